# Optimizing an MI355X kernel written in HIP

```python
import math
import jax, jax.numpy as jnp
from jax import lax
import numpy as np

D_MODEL = 2048
BATCH = 4
SEQ = 2048
DEPTH = 1
DEC_BATCH = 128
DEC_SEQ = 4
PAST_LEN = 16384
PAGE_SIZE = 128

MIX_WIDTH = D_MODEL
S5_WIDTH = MIX_WIDTH // 2
S5_GROUP = 16
S5_GROUPS = S5_WIDTH // S5_GROUP
S5_STATE = 64
GLA_WIDTH = MIX_WIDTH - S5_WIDTH
GLA_HEADS = 4
GLA_DV = GLA_WIDTH // GLA_HEADS
GLA_DK = GLA_DV // 2
GLA_QK_WIDTH = GLA_HEADS * GLA_DK
GLA_RANK = 16
GLA_TAU = 16.0
GLA_CHUNK = 64
N_MEM = 256
X_HEADS = 4
X_HEAD_DIM = D_MODEL // X_HEADS
D_FF = 5632
CONV_W = 3
EPS = 1e-6
IN_WIDTH = S5_WIDTH + 2 * GLA_QK_WIDTH + GLA_WIDTH + GLA_RANK + GLA_WIDTH
SPLITS = [S5_WIDTH,
          S5_WIDTH + GLA_QK_WIDTH,
          S5_WIDTH + 2 * GLA_QK_WIDTH,
          S5_WIDTH + 2 * GLA_QK_WIDTH + GLA_WIDTH,
          S5_WIDTH + 2 * GLA_QK_WIDTH + GLA_WIDTH + GLA_RANK]

kernel_name = "hymba_s5_gla_memxattn_convffn_step"


def _rmsnorm(x, gain):
    xf = x.astype(jnp.float32)
    r = lax.rsqrt(jnp.mean(xf * xf, axis=-1, keepdims=True) + EPS)
    return (xf * r).astype(x.dtype) * gain.astype(x.dtype)


def _complex_affine_combine(e1, e2):
    a1r, a1i, b1r, b1i = e1
    a2r, a2i, b2r, b2i = e2
    ar = a2r * a1r - a2i * a1i
    ai = a2r * a1i + a2i * a1r
    br = a2r * b1r - a2i * b1i + b2r
    bi = a2r * b1i + a2i * b1r + b2i
    return (ar, ai, br, bi)


def _s5_mixer(u, h0_re, h0_im, lam_re, lam_im, log_dt, b_re, b_im, c_re, c_im, d, w_glu, b_glu):
    bsz, L, _ = u.shape
    f32 = jnp.float32
    uf = u.astype(f32).reshape(bsz, L, S5_GROUPS, S5_GROUP)
    dt = jnp.exp(log_dt.astype(f32))[:, None]
    lr = lam_re.astype(f32)
    li = lam_im.astype(f32)
    mag = jnp.exp(lr * dt)
    a_re = mag * jnp.cos(li * dt)
    a_im = mag * jnp.sin(li * dt)
    den = lr * lr + li * li
    p_re = a_re - 1.0
    q_re = (p_re * lr + a_im * li) / den
    q_im = (a_im * lr - p_re * li) / den
    br = b_re.astype(f32)
    bi = b_im.astype(f32)
    bb_re = q_re[..., None] * br - q_im[..., None] * bi
    bb_im = q_re[..., None] * bi + q_im[..., None] * br
    bu_re = jnp.einsum('blgp,gnp->blgn', uf, bb_re)
    bu_im = jnp.einsum('blgp,gnp->blgn', uf, bb_im)
    h0r = h0_re.astype(f32)
    h0i = h0_im.astype(f32)
    bu_re = bu_re.at[:, 0].add(a_re * h0r - a_im * h0i)
    bu_im = bu_im.at[:, 0].add(a_re * h0i + a_im * h0r)
    a_re_l = jnp.broadcast_to(a_re, bu_re.shape)
    a_im_l = jnp.broadcast_to(a_im, bu_im.shape)
    _, _, h_re, h_im = lax.associative_scan(
        _complex_affine_combine, (a_re_l, a_im_l, bu_re, bu_im), axis=1)
    y = (jnp.einsum('blgn,gpn->blgp', h_re, c_re.astype(f32))
         - jnp.einsum('blgn,gpn->blgp', h_im, c_im.astype(f32))
         + d.astype(f32) * uf)
    z = jax.nn.gelu(y, approximate=False)
    z = z * jax.nn.sigmoid(jnp.einsum('blgp,gpq->blgq', z, w_glu.astype(f32)) + b_glu.astype(f32))
    return z.reshape(bsz, L, S5_WIDTH), h_re[:, -1], h_im[:, -1]


def _gla_chunked(q, k, v, log_a, s0):
    bsz, L = q.shape[0], q.shape[1]
    c = min(GLA_CHUNK, L)
    n = L // c

    def to_chunks(t):
        return t.reshape(bsz, n, c, GLA_HEADS, t.shape[-1]).transpose(1, 0, 3, 2, 4)

    qc, kc, vc, gc = to_chunks(q), to_chunks(k), to_chunks(v), to_chunks(log_a)
    bcum = jnp.cumsum(gc, axis=3)
    b_last = bcum[..., -1:, :]
    q_t = qc * jnp.exp(bcum)
    k_t = kc * jnp.exp(-bcum)
    k_end = kc * jnp.exp(b_last - bcum)
    causal = jnp.tril(jnp.ones((c, c), dtype=bool))
    scores = jnp.where(causal, jnp.einsum('nbhtk,nbhsk->nbhts', q_t, k_t), 0.0)
    o_intra = jnp.einsum('nbhts,nbhsv->nbhtv', scores, vc)
    kv_chunk = jnp.einsum('nbhsk,nbhsv->nbhkv', k_end, vc)
    decay = jnp.exp(b_last[..., 0, :])

    def step(s, inp):
        q_i, kv_i, d_i = inp
        o = jnp.einsum('bhtk,bhkv->bhtv', q_i, s)
        s = d_i[..., None] * s + kv_i
        return s, o

    s_fin, o_inter = lax.scan(step, s0, (q_t, kv_chunk, decay))
    o = (o_intra + o_inter).transpose(1, 0, 3, 2, 4).reshape(bsz, L, GLA_HEADS, GLA_DV)
    return o, s_fin


def _gla_mixer(q, k, v, g_low, r, s0, w_g2, b_g, norm_gla):
    bsz, L, _ = q.shape
    f32 = jnp.float32
    qf = q.astype(f32).reshape(bsz, L, GLA_HEADS, GLA_DK) * (GLA_DK ** -0.5)
    kf = k.astype(f32).reshape(bsz, L, GLA_HEADS, GLA_DK)
    vf = v.astype(f32).reshape(bsz, L, GLA_HEADS, GLA_DV)
    log_a = jax.nn.log_sigmoid((g_low @ w_g2 + b_g).astype(f32)) / GLA_TAU
    log_a = log_a.reshape(bsz, L, GLA_HEADS, GLA_DK)
    o, s_fin = _gla_chunked(qf, kf, vf, log_a, s0.astype(f32))
    o = _rmsnorm(o, norm_gla).reshape(bsz, L, GLA_WIDTH).astype(q.dtype)
    return o * jax.nn.silu(r), s_fin


def _mem_kv(mem, norm_mem, w_xk, w_xv):
    bsz = mem.shape[0]
    m = _rmsnorm(mem, norm_mem)
    mk = (m @ w_xk).reshape(bsz, N_MEM, X_HEADS, X_HEAD_DIM)
    mv = (m @ w_xv).reshape(bsz, N_MEM, X_HEADS, X_HEAD_DIM)
    return mk, mv


def _cross_attn(x, mk, mv, norm_x, w_xq, w_xo):
    bsz, L, _ = x.shape
    h = _rmsnorm(x, norm_x)
    q = (h @ w_xq).reshape(bsz, L, X_HEADS, X_HEAD_DIM)
    s = jnp.einsum('blhd,bmhd->bhlm', q, mk.astype(q.dtype)).astype(jnp.float32) * (X_HEAD_DIM ** -0.5)
    p = jax.nn.softmax(s, axis=-1).astype(x.dtype)
    o = jnp.einsum('bhlm,bmhd->blhd', p, mv.astype(x.dtype)).reshape(bsz, L, D_MODEL)
    return o @ w_xo


def _conv_ffn(x, buf, norm_ffn, w_up, conv_w, conv_b, w_down):
    L = x.shape[1]
    h = _rmsnorm(x, norm_ffn)
    hu = h @ w_up
    a, g = jnp.split(hu, [D_FF], axis=-1)
    ext = jnp.concatenate([buf.astype(a.dtype), a], axis=1)
    conv = conv_b
    for i in range(CONV_W):
        conv = conv + ext[:, i:i + L] * conv_w[i]
    out = (jax.nn.gelu(conv, approximate=False) * g) @ w_down
    return out, ext[:, -(CONV_W - 1):]


def _layer(x, mk, mv, s5_re, s5_im, gla_s, conv_buf, w):
    h = _rmsnorm(x, w['norm_mix'])
    proj = h @ w['w_in']
    u, q, k, v, g_low, r = jnp.split(proj, SPLITS, axis=-1)
    y_s5, s5_re_n, s5_im_n = _s5_mixer(u, s5_re, s5_im, w['lam_re'], w['lam_im'], w['log_dt'],
                                      w['b_re'], w['b_im'], w['c_re'], w['c_im'], w['d'],
                                      w['w_glu'], w['b_glu'])
    y_s5 = _rmsnorm(y_s5.astype(x.dtype), w['norm_s5_out'])
    y_gla, gla_n = _gla_mixer(q, k, v, g_low, r, gla_s, w['w_g2'], w['b_g'], w['norm_gla_out'])
    x = x + jnp.concatenate([y_s5, y_gla], axis=-1) @ w['w_out']
    x = x + _cross_attn(x, mk, mv, w['norm_xattn'], w['w_xq'], w['w_xo'])
    ffn_out, conv_n = _conv_ffn(x, conv_buf, w['norm_ffn'], w['w_up'], w['conv_w'], w['conv_b'], w['w_down'])
    x = x + ffn_out
    return x, s5_re_n, s5_im_n, gla_n, conv_n


def setup_inputs(seed: int = 0) -> dict:
    key = jax.random.key(seed)
    ks = jax.random.split(key, 48)
    f32 = jnp.float32

    def nrm(k, shape, scale):
        return scale * jax.random.normal(k, shape, f32)

    def gain(k, shape):
        return 1.0 + nrm(k, shape, 0.01)

    Ld = DEPTH
    n_idx = jnp.arange(S5_STATE, dtype=f32)
    inp = {}
    inp['x_prompt'] = nrm(ks[0], (BATCH, SEQ, D_MODEL), 1.0)
    inp['x_sample'] = nrm(ks[1], (DEC_BATCH, DEC_SEQ, D_MODEL), 1.0)
    inp['mem_prompt'] = nrm(ks[2], (BATCH, N_MEM, D_MODEL), 1.0)
    inp['cache_mem_k'] = nrm(ks[3], (Ld, DEC_BATCH, N_MEM, X_HEADS, X_HEAD_DIM), 1.0)
    inp['cache_mem_v'] = nrm(ks[4], (Ld, DEC_BATCH, N_MEM, X_HEADS, X_HEAD_DIM), 1.0)
    inp['state_s5_re'] = nrm(ks[5], (Ld, DEC_BATCH, S5_GROUPS, S5_STATE), 0.5)
    inp['state_s5_im'] = nrm(ks[6], (Ld, DEC_BATCH, S5_GROUPS, S5_STATE), 0.5)
    inp['state_gla'] = nrm(ks[7], (Ld, DEC_BATCH, GLA_HEADS, GLA_DK, GLA_DV), 0.3)
    inp['state_conv'] = nrm(ks[8], (Ld, DEC_BATCH, CONV_W - 1, D_FF), 1.0)
    inp['norm_mix'] = gain(ks[9], (Ld, D_MODEL))
    inp['w_in'] = nrm(ks[10], (Ld, D_MODEL, IN_WIDTH), D_MODEL ** -0.5)
    inp['s5_lambda_re'] = -0.5 + nrm(ks[11], (Ld, S5_GROUPS, S5_STATE), 0.01)
    inp['s5_lambda_im'] = jnp.pi * n_idx + nrm(ks[12], (Ld, S5_GROUPS, S5_STATE), 0.01)
    inp['s5_log_dt'] = jax.random.uniform(ks[13], (Ld, S5_GROUPS), f32, math.log(0.001), math.log(0.1))
    inp['s5_b_re'] = nrm(ks[14], (Ld, S5_GROUPS, S5_STATE, S5_GROUP), (2.0 * S5_GROUP) ** -0.5)
    inp['s5_b_im'] = nrm(ks[15], (Ld, S5_GROUPS, S5_STATE, S5_GROUP), (2.0 * S5_GROUP) ** -0.5)
    inp['s5_c_re'] = nrm(ks[16], (Ld, S5_GROUPS, S5_GROUP, S5_STATE), (2.0 * S5_STATE) ** -0.5)
    inp['s5_c_im'] = nrm(ks[17], (Ld, S5_GROUPS, S5_GROUP, S5_STATE), (2.0 * S5_STATE) ** -0.5)
    inp['s5_d'] = nrm(ks[18], (Ld, S5_GROUPS, S5_GROUP), 1.0)
    inp['s5_w_glu'] = nrm(ks[19], (Ld, S5_GROUPS, S5_GROUP, S5_GROUP), S5_GROUP ** -0.5)
    inp['s5_b_glu'] = nrm(ks[20], (Ld, S5_GROUPS, S5_GROUP), 0.01)
    inp['norm_s5_out'] = gain(ks[21], (Ld, S5_WIDTH))
    inp['gla_w_g2'] = nrm(ks[22], (Ld, GLA_RANK, GLA_QK_WIDTH), GLA_RANK ** -0.5)
    inp['gla_b_g'] = nrm(ks[23], (Ld, GLA_QK_WIDTH), 0.1)
    inp['norm_gla_out'] = gain(ks[24], (Ld, GLA_DV))
    inp['w_out'] = nrm(ks[25], (Ld, MIX_WIDTH, D_MODEL), MIX_WIDTH ** -0.5)
    inp['norm_xattn'] = gain(ks[26], (Ld, D_MODEL))
    inp['norm_mem'] = gain(ks[27], (Ld, D_MODEL))
    inp['w_xq'] = nrm(ks[28], (Ld, D_MODEL, D_MODEL), D_MODEL ** -0.5)
    inp['w_xk'] = nrm(ks[29], (Ld, D_MODEL, D_MODEL), D_MODEL ** -0.5)
    inp['w_xv'] = nrm(ks[30], (Ld, D_MODEL, D_MODEL), D_MODEL ** -0.5)
    inp['w_xo'] = nrm(ks[31], (Ld, D_MODEL, D_MODEL), D_MODEL ** -0.5)
    inp['norm_ffn'] = gain(ks[32], (Ld, D_MODEL))
    inp['w_up'] = nrm(ks[33], (Ld, D_MODEL, 2 * D_FF), D_MODEL ** -0.5)
    inp['conv_w'] = nrm(ks[34], (Ld, CONV_W, D_FF), CONV_W ** -0.5)
    inp['conv_b'] = nrm(ks[35], (Ld, D_FF), 0.01)
    inp['w_down'] = nrm(ks[36], (Ld, D_FF, D_MODEL), D_FF ** -0.5)
    inp['norm_final'] = gain(ks[37], (D_MODEL,))
    return inp


def reference(x_prompt, x_sample, mem_prompt, cache_mem_k, cache_mem_v, state_s5_re, state_s5_im,
              state_gla, state_conv, norm_mix, w_in, s5_lambda_re, s5_lambda_im, s5_log_dt,
              s5_b_re, s5_b_im, s5_c_re, s5_c_im, s5_d, s5_w_glu, s5_b_glu, norm_s5_out,
              gla_w_g2, gla_b_g, norm_gla_out, w_out, norm_xattn, norm_mem, w_xq, w_xk, w_xv,
              w_xo, norm_ffn, w_up, conv_w, conv_b, w_down, norm_final):
    f32 = jnp.float32
    bp = x_prompt.shape[0]
    xp = x_prompt
    xs = x_sample
    p_mk, p_mv, p_re, p_im, p_gla, p_conv = [], [], [], [], [], []
    s_re, s_im, s_gla, s_conv = [], [], [], []
    for l in range(DEPTH):
        w = dict(norm_mix=norm_mix[l], w_in=w_in[l], lam_re=s5_lambda_re[l], lam_im=s5_lambda_im[l],
                 log_dt=s5_log_dt[l], b_re=s5_b_re[l], b_im=s5_b_im[l], c_re=s5_c_re[l],
                 c_im=s5_c_im[l], d=s5_d[l], w_glu=s5_w_glu[l], b_glu=s5_b_glu[l],
                 norm_s5_out=norm_s5_out[l], w_g2=gla_w_g2[l], b_g=gla_b_g[l],
                 norm_gla_out=norm_gla_out[l], w_out=w_out[l], norm_xattn=norm_xattn[l],
                 w_xq=w_xq[l], w_xo=w_xo[l], norm_ffn=norm_ffn[l], w_up=w_up[l],
                 conv_w=conv_w[l], conv_b=conv_b[l], w_down=w_down[l])
        mk, mv = _mem_kv(mem_prompt, norm_mem[l], w_xk[l], w_xv[l])
        z_s5 = jnp.zeros((bp, S5_GROUPS, S5_STATE), f32)
        z_gla = jnp.zeros((bp, GLA_HEADS, GLA_DK, GLA_DV), f32)
        z_conv = jnp.zeros((bp, CONV_W - 1, D_FF), xp.dtype)
        xp, n_re, n_im, n_gla, n_conv = _layer(xp, mk, mv, z_s5, z_s5, z_gla, z_conv, w)
        p_mk.append(mk)
        p_mv.append(mv)
        p_re.append(n_re)
        p_im.append(n_im)
        p_gla.append(n_gla)
        p_conv.append(n_conv)
        xs, m_re, m_im, m_gla, m_conv = _layer(xs, cache_mem_k[l], cache_mem_v[l], state_s5_re[l],
                                               state_s5_im[l], state_gla[l], state_conv[l], w)
        s_re.append(m_re)
        s_im.append(m_im)
        s_gla.append(m_gla)
        s_conv.append(m_conv)
    y_prompt = _rmsnorm(xp, norm_final)
    y_sample = _rmsnorm(xs, norm_final)
    return (y_prompt, y_sample,
            jnp.stack(p_mk), jnp.stack(p_mv), jnp.stack(p_re), jnp.stack(p_im),
            jnp.stack(p_gla), jnp.stack(p_conv),
            jnp.stack(s_re), jnp.stack(s_im), jnp.stack(s_gla), jnp.stack(s_conv))
```

```cpp
#include <hip/hip_runtime.h>
#include <cstdio>
#include <cstdint>

#define LAS __attribute__((address_space(3)))
typedef unsigned short bf16_t;
typedef short bf16x8 __attribute__((ext_vector_type(8)));
typedef float f32x4 __attribute__((ext_vector_type(4)));
typedef float f32x2 __attribute__((ext_vector_type(2)));
typedef unsigned u32x4 __attribute__((ext_vector_type(4)));
typedef unsigned u32x2 __attribute__((ext_vector_type(2)));

#ifndef MK_N_LAUNCHES
#define MK_N_LAUNCHES 1
#endif
#ifndef MK_PH_END
#define MK_PH_END 14
#endif

constexpr int DM = 2048, NPR = 8192, NSM = 512, MT = 8704;
constexpr int DFF = 5632, NIN = 4352, NMEMR = 1024;
constexpr float EPS = 1e-6f;
constexpr size_t O_Y = 0, O_MK = 17825792, O_MV = 19922944, O_S5RE_P = 22020096, O_S5IM_P = 22036480, O_GLA_P = 22052864,
                 O_CONV_P = 22577152, O_S5RE_S = 22622208, O_S5IM_S = 23146496, O_GLA_S = 23670784, O_CONV_S = 40448000, O_END = 41889792;
constexpr size_t MiB = 1u << 20;
constexpr size_t WS_CTL = 0, CTL_ZERO_BYTES = 1 * MiB;
constexpr size_t WS_R1 = 1 * MiB, WS_RMEM = 1 * MiB + 65536, WS_R2 = 1 * MiB + 131072, WS_R3 = 1 * MiB + 196608;
constexpr size_t WS_SS2 = 2 * MiB, WS_SS3 = 4 * MiB, WS_SS4 = 6 * MiB, WS_S5SS = 8 * MiB, WS_GSS = 11 * MiB, WS_GLOW = 12 * MiB;
constexpr size_t WS_KT = 13 * MiB, WS_A16 = 14 * MiB, WS_A4 = 14 * MiB + 65536, WS_M2T = 15 * MiB, WS_M3T = 19 * MiB;
constexpr size_t WS_WIN = 24 * MiB, WS_WOUT = 42 * MiB, WS_WXQ = 50 * MiB, WS_WXKV = 58 * MiB, WS_WXO = 74 * MiB, WS_WUP = 82 * MiB, WS_WDN = 126 * MiB;
constexpr size_t WS_XB = 148 * MiB, WS_MEMB = 182 * MiB, WS_U = 186 * MiB, WS_PROJ = 203 * MiB, WS_MKB = 254 * MiB, WS_MVT = 258 * MiB;
constexpr size_t WS_YCAT = 262 * MiB, WS_OG = 296 * MiB, WS_X2 = 313 * MiB, WS_X2B = 381 * MiB, WS_QX = 415 * MiB, WS_OX = 449 * MiB;
constexpr size_t WS_X3 = 483 * MiB, WS_X3B = 551 * MiB, WS_AB = 585 * MiB, WS_GB = 679 * MiB, WS_ACT = 773 * MiB, WS_END = 867 * MiB;
constexpr size_t WS_KVC = WS_AB, WS_SPREV = WS_GB, WS_QTG = WS_ACT, WS_DECG = WS_ACT + 16 * MiB, WS_RS5 = WS_GSS;
constexpr size_t WS_HAL = WS_X3, WS_HFA = WS_X3 + 2 * MiB, WS_HFG = WS_X3 + 4 * MiB;
constexpr size_t WS_SLAB = 867 * MiB, WS_END2 = 931 * MiB;
constexpr int CW_BAR = 4096;

constexpr int NWAVES = 8;
constexpr int LDS_BYTES = 163840;
constexpr int QPRE_OFF = 147456;
constexpr int MISC_OFF = 144384;

typedef __bf16 bf16x2_t __attribute__((ext_vector_type(2)));
__device__ __forceinline__ unsigned cvt_pk_bf16(float lo, float hi) { const f32x2 v = {lo, hi}; const bf16x2_t b = __builtin_convertvector(v, bf16x2_t); return __builtin_bit_cast(unsigned, b); }
__device__ __forceinline__ bf16_t f2bf(float f) { return (bf16_t)(cvt_pk_bf16(f, 0.f) & 0xffffu); }
__device__ __forceinline__ float bf2f(bf16_t v) { return __uint_as_float(((unsigned)v) << 16); }
__device__ __forceinline__ float bflo(unsigned w) { return __uint_as_float(w << 16); }
__device__ __forceinline__ float bfhi(unsigned w) { return __uint_as_float(w & 0xffff0000u); }
__device__ __forceinline__ float gelu1(float v) {
    const float av = fabsf(v), d = av * 0.2316418882f + 1.0f; const float t = __builtin_amdgcn_rcpf(d);
    float q = t * 0.5307027145f + (-0.7265760135f); q = q * t + 0.7107068705f; q = q * t + (-0.142248368f); q = q * t + 0.127414796f; q = q * t;
    const float e = __builtin_amdgcn_exp2f((v * v) * (-0.72134752044f));
    const float m = v * (q * e); return v < 0.f ? m : v - m;
}
__device__ __forceinline__ float sigmoid1(float x) { return 1.0f / (1.0f + __expf(-x)); }
__device__ __forceinline__ float logsigmoid1(float z) { return fminf(z, 0.f) - log1pf(expf(-fabsf(z))); }
__device__ __forceinline__ float wave_sum(float v) {
#pragma unroll
    for (int o = 1; o < 64; o <<= 1) v += __shfl_xor(v, o);
    return v;
}
__device__ __forceinline__ float wave_max(float v) {
#pragma unroll
    for (int o = 1; o < 64; o <<= 1) v = fmaxf(v, __shfl_xor(v, o));
    return v;
}
__device__ __forceinline__ f32x4 mma16(bf16x8 bfrag, bf16x8 afrag, f32x4 acc) { return __builtin_amdgcn_mfma_f32_16x16x32_bf16(bfrag, afrag, acc, 0, 0, 0); }
__device__ __forceinline__ bf16x8 ldg8(const bf16_t* p) { return *(const bf16x8*)p; }
__device__ __forceinline__ bf16x8 pack8(const f32x4 a, const f32x4 b) {
    u32x4 w; w.x = cvt_pk_bf16(a[0], a[1]); w.y = cvt_pk_bf16(a[2], a[3]); w.z = cvt_pk_bf16(b[0], b[1]); w.w = cvt_pk_bf16(b[2], b[3]);
    return __builtin_bit_cast(bf16x8, w);
}

struct Args { const float* in[38]; float* out; unsigned char* ws; int ph_lo, ph_hi, li, pad; };

namespace pg8 {
constexpr int BM = 256, BK = 64, HALF = 128, HTB = HALF * BK * 2, STAGE_BYTES = 8 * HTB, NXCD = 8, WGM = 8;
__device__ __forceinline__ int lds_byte(int r, int c) { const int st = (r >> 4) * 2 + (c >> 5), rr = r & 15, cc = c & 31, ob = rr * 64 + cc * 2; return st * 1024 + (ob ^ (((ob >> 9) & 1) << 5)); }
__device__ __forceinline__ void stage_rc(int b, int& R, int& C) { const int st = b / 1024, sb = b % 1024, swz = sb ^ (((sb >> 9) & 1) << 5); R = (st >> 1) * 16 + swz / 64; C = (st & 1) * 32 + (swz % 64) / 2; }
__device__ __forceinline__ int perm32(int rho) { const int n = rho >> 4, i = rho & 15; return 8 * (i >> 2) + 4 * n + (i & 3); }

struct Unit { const char* pa; const char* pb; int pm, pn, job, nt, ks; };
struct JobDesc { const char* A; const char* B; int nM, nN, pm0; };
template <int NJ> struct SchedJ {
    JobDesc jb[NJ]; int G, c, nt; size_t tstep;
    __device__ __forceinline__ bool next(int i, Unit& u) const {
        long L = (long)i * G + c;
#pragma unroll
        for (int j = 0; j < NJ; ++j) {
            const int nM = jb[j].nM, nN = jb[j].nN, nwg = nM * nN;
            if (L < nwg) {
                int wgid = (int)L; { const int q = nwg / NXCD, r = nwg % NXCD, xcd = wgid % NXCD, off = wgid / NXCD; wgid = (xcd < r ? xcd * (q + 1) : r * (q + 1) + (xcd - r) * q) + off; }
                const int nig = WGM * nN, gid = wgid / nig, fm = gid * WGM, gsz = (nM - fm) < WGM ? (nM - fm) : WGM;
                const int pml = fm + ((wgid % nig) % gsz); u.pm = jb[j].pm0 + pml; u.pn = (wgid % nig) / gsz; u.job = j; u.nt = nt; u.ks = 0;
                u.pa = jb[j].A + (size_t)pml * tstep; u.pb = jb[j].B + (size_t)u.pn * tstep; return true;
            }
            L -= nwg;
        }
        return false;
    }
};

struct SchedMS {
    const char* A; const char* B; int G, c, nt, nsl, ntsl; size_t tstep;
    __device__ __forceinline__ bool next(int i, Unit& u) const {
        const long L = (long)i * G + c;
        if (L < 256) {
            int wgid = (int)L; { const int xcd = wgid % NXCD, off = wgid / NXCD; wgid = xcd * 32 + off; }
            const int nig = WGM * 8, gid = wgid / nig, fm = gid * WGM;
            u.pm = fm + ((wgid % nig) % WGM); u.pn = (wgid % nig) / WGM; u.job = 0; u.nt = nt; u.ks = 0;
            u.pa = A + (size_t)u.pm * tstep; u.pb = B + (size_t)u.pn * tstep; return true;
        }
        const long s_ = L - 256;
        if (s_ < 16 * nsl) {
            const int ts = (int)s_ / nsl, ks = (int)s_ - ts * nsl;
            u.pm = 32 + (ts >> 3); u.pn = ts & 7; u.job = 1; u.nt = ntsl; u.ks = ks;
            u.pa = A + (size_t)u.pm * tstep + (size_t)ks * ntsl * 128; u.pb = B + (size_t)u.pn * tstep + (size_t)ks * ntsl * 128; return true;
        }
        return false;
    }
};

template <class Epi, class Sched>
__device__ __forceinline__ void gemm_phase(LAS unsigned char* lds, const int K, const Sched& S, const Epi& E, const int tid) {
    const int wid = __builtin_amdgcn_readfirstlane(tid >> 6), lane = tid & 63, wr = wid >> 2, wc = wid & 3, fr = lane & 15, fq = lane >> 4;
    unsigned voffA[2], voffB[2];
#pragma unroll
    for (int i = 0; i < 2; ++i) { int R, C; stage_rc(tid * 16 + i * 8192, R, C); const int Rb = (R & ~31) + perm32(R & 31);
        voffA[i] = (unsigned)(R * K + C) * 2u; voffB[i] = (unsigned)(Rb * K + C) * 2u; }
    const size_t kstep = (size_t)(BK * 2);
    const size_t hstep = (size_t)HALF * K * 2;
    const unsigned ldsw = (unsigned)wid * 1024u;
    const int aoff = lds_byte(wr * 64 + fr, fq * 8), boff = lds_byte(wc * 32 + fr, fq * 8);
#define PG8_SA(b, h) (((b) * 2 + (h)) * HTB)
#define PG8_SB(b, h) ((4 + (b) * 2 + (h)) * HTB)
#define PG8_STAGE(bufoff, gbase, voff) do { _Pragma("unroll") for (int _i = 0; _i < 2; ++_i) \
        __builtin_amdgcn_global_load_lds((const unsigned*)((const char*)(gbase) + (voff)[_i]), (LAS unsigned*)(lds + (bufoff) + ldsw + _i * 8192), 16, 0, 0); } while (0)
#define PG8_LDA(dst, b, h) do { _Pragma("unroll") for (int m = 0; m < 4; ++m) _Pragma("unroll") for (int k = 0; k < 2; ++k) dst[m][k] = *(const LAS bf16x8*)(lds + PG8_SA(b, h) + aoff + m * 2048 + k * 1024); } while (0)
#define PG8_LDB(dst, b, h) do { _Pragma("unroll") for (int n = 0; n < 2; ++n) _Pragma("unroll") for (int k = 0; k < 2; ++k) dst[n][k] = *(const LAS bf16x8*)(lds + PG8_SB(b, h) + boff + n * 2048 + k * 1024); } while (0)
#define PG8_MMA(ai, bj, At, Bt) do { __builtin_amdgcn_s_setprio(1); _Pragma("unroll") for (int m = 0; m < 4; ++m) _Pragma("unroll") for (int n = 0; n < 2; ++n) _Pragma("unroll") for (int k = 0; k < 2; ++k) \
        acc[ai][bj][m][n] = __builtin_amdgcn_mfma_f32_16x16x32_bf16(Bt[n][k], At[m][k], acc[ai][bj][m][n], 0, 0, 0); __builtin_amdgcn_s_setprio(0); } while (0)
#define PG8_WAIT_V(n) asm volatile("s_waitcnt vmcnt(" #n ")" ::: "memory")
#define PG8_WAIT_L(n) asm volatile("s_waitcnt lgkmcnt(" #n ")" ::: "memory")
#define PG8_BAR __builtin_amdgcn_s_barrier()
#define PG8_SCHED __builtin_amdgcn_sched_barrier(0)
    Unit cur, nxt; int ui = 0;
    if (!S.next(0, cur)) return;
    f32x4 acc[2][2][4][2];
#pragma unroll
    for (int a = 0; a < 2; ++a)
#pragma unroll
        for (int b = 0; b < 2; ++b)
#pragma unroll
            for (int m = 0; m < 4; ++m)
#pragma unroll
                for (int n = 0; n < 2; ++n) acc[a][b][m][n] = (f32x4){0.f, 0.f, 0.f, 0.f};
    bf16x8 At[4][2], B0[2][2], B1[2][2];
    float pre[2][4];
    const char* cA = cur.pa; const char* cB = cur.pb;
    PG8_STAGE(PG8_SB(0, 0), cB, voffB); PG8_STAGE(PG8_SB(0, 1), cB + hstep, voffB); PG8_STAGE(PG8_SA(0, 0), cA, voffA); PG8_STAGE(PG8_SA(0, 1), cA + hstep, voffA);
    if (wr == 1) PG8_BAR;
    PG8_WAIT_V(2); PG8_BAR;
    PG8_STAGE(PG8_SB(1, 0), cB + kstep, voffB); PG8_STAGE(PG8_SA(1, 0), cA + kstep, voffA); PG8_STAGE(PG8_SB(1, 1), cB + hstep + kstep, voffB);
    PG8_WAIT_V(6); PG8_BAR;
    for (;;) {
        const bool has_next = S.next(ui + 1, nxt);
        const char* nA = has_next ? nxt.pa : cA; const char* nB = has_next ? nxt.pb : cB;
        const int nt = cur.nt;
        for (int t = 0; t < nt; t += 2) {
            const bool last = (t == nt - 2);
            const char* a1 = cA + (size_t)(t + 1) * kstep;
            const char* a2 = last ? nA : cA + (size_t)(t + 2) * kstep; const char* b2 = last ? nB : cB + (size_t)(t + 2) * kstep;
            const char* a3 = a2 + kstep; const char* b3 = b2 + kstep;
            if (last) E.prefetch(cur, wr, fr, pre);
            PG8_LDB(B0, 0, 0); PG8_LDB(B1, 0, 1); PG8_SCHED; PG8_LDA(At, 0, 0); PG8_STAGE(PG8_SA(1, 1), a1 + hstep, voffA);
            PG8_WAIT_V(8); PG8_WAIT_L(0); PG8_BAR; PG8_MMA(0, 0, At, B0); PG8_MMA(0, 1, At, B1); PG8_BAR; PG8_SCHED;
            PG8_LDA(At, 0, 1); PG8_STAGE(PG8_SB(0, 0), b2, voffB); PG8_STAGE(PG8_SB(0, 1), b2 + hstep, voffB); PG8_STAGE(PG8_SA(0, 0), a2, voffA);
            PG8_WAIT_V(8); PG8_WAIT_L(0); PG8_BAR; PG8_MMA(1, 0, At, B0); PG8_MMA(1, 1, At, B1); PG8_BAR; PG8_SCHED;
            PG8_LDB(B0, 1, 0); PG8_LDB(B1, 1, 1); PG8_SCHED; PG8_LDA(At, 1, 0); PG8_STAGE(PG8_SA(0, 1), a2 + hstep, voffA);
            PG8_WAIT_V(8); PG8_WAIT_L(0); PG8_BAR; PG8_MMA(0, 0, At, B0); PG8_MMA(0, 1, At, B1); PG8_BAR; PG8_SCHED;
            PG8_LDA(At, 1, 1); PG8_STAGE(PG8_SB(1, 0), b3, voffB); PG8_STAGE(PG8_SB(1, 1), b3 + hstep, voffB); PG8_STAGE(PG8_SA(1, 0), a3, voffA);
            PG8_WAIT_V(8); PG8_WAIT_L(0); PG8_BAR; PG8_MMA(1, 0, At, B0); PG8_MMA(1, 1, At, B1); PG8_BAR; PG8_SCHED;
        }
        if (wr == 0) PG8_BAR;
        E(acc, cur, wr, wc, fr, fq, pre);
        if (!has_next) break;
#pragma unroll
        for (int a = 0; a < 2; ++a)
#pragma unroll
            for (int b = 0; b < 2; ++b)
#pragma unroll
                for (int m = 0; m < 4; ++m)
#pragma unroll
                    for (int n = 0; n < 2; ++n) acc[a][b][m][n] = (f32x4){0.f, 0.f, 0.f, 0.f};
        cur = nxt; cA = nA; cB = nB; ++ui;
        if (wr == 1) PG8_BAR;
    }
    PG8_WAIT_V(0);
    PG8_BAR;
#undef PG8_SA
#undef PG8_SB
#undef PG8_STAGE
#undef PG8_LDA
#undef PG8_LDB
#undef PG8_MMA
#undef PG8_WAIT_V
#undef PG8_WAIT_L
#undef PG8_BAR
#undef PG8_SCHED
}
}

typedef f32x4 AccT[2][2][4][2];
extern __shared__ __attribute__((aligned(16))) unsigned char smem[];

__device__ __forceinline__ void row_rs8(const float* SS, int rowbase  , int fq, float (&rs)[2][4]) {
#pragma unroll
    for (int ai = 0; ai < 2; ++ai)
#pragma unroll
        for (int m = 0; m < 4; ++m) {
            const int r = rowbase + ai * 128 + m * 16;
            const f32x4 a = *(const f32x4*)(SS + (size_t)r * 32 + fq * 8), b = *(const f32x4*)(SS + (size_t)r * 32 + fq * 8 + 4);
            float s = (a[0] + a[1]) + (a[2] + a[3]) + (b[0] + b[1]) + (b[2] + b[3]);
            s += __shfl_xor(s, 16); s += __shfl_xor(s, 32);
            rs[ai][m] = rsqrtf(s * (1.0f / 2048.0f) + EPS);
        }
}
__device__ __forceinline__ void st_bf16x8_nt(bf16_t* p, const f32x4 v0, const f32x4 v1) {
    u32x4 w; w.x = cvt_pk_bf16(v0[0], v0[1]); w.y = cvt_pk_bf16(v0[2], v0[3]); w.z = cvt_pk_bf16(v1[0], v1[1]); w.w = cvt_pk_bf16(v1[2], v1[3]);
    __builtin_nontemporal_store(w, (u32x4*)p);
}
__device__ __forceinline__ void st_bf16x8(bf16_t* p, const f32x4 v0, const f32x4 v1) {
    u32x4 w; w.x = cvt_pk_bf16(v0[0], v0[1]); w.y = cvt_pk_bf16(v0[2], v0[3]); w.z = cvt_pk_bf16(v1[0], v1[1]); w.w = cvt_pk_bf16(v1[2], v1[3]);
    *(u32x4*)p = w;
}

__device__ __forceinline__ void slab_store(const AccT& acc, const pg8::Unit& u, float* SLAB, int nsl, int wr, int wc, int fr, int fq) {
    const int ts = (u.pm - 32) * 8 + u.pn; float* base = SLAB + (size_t)(ts * nsl + u.ks) * 65536;
#pragma unroll
    for (int ai = 0; ai < 2; ++ai)
#pragma unroll
        for (int m = 0; m < 4; ++m) { const int r = ai * 128 + wr * 64 + m * 16 + fr;
#pragma unroll
            for (int bj = 0; bj < 2; ++bj) { float* p = base + (size_t)r * 256 + bj * 128 + wc * 32 + fq * 8; *(f32x4*)p = acc[ai][bj][m][0]; *(f32x4*)(p + 4) = acc[ai][bj][m][1]; } }
}

struct EpiP1 {
    const float* r1; const float* rmem; bf16_t* U; bf16_t* PROJ; float* GLOW; float* out; bf16_t* MKB; bf16_t* MVT;
    __device__ __forceinline__ void prefetch(const pg8::Unit& u, int wr, int fr, float (&pre)[2][4]) const {
        const float* rp = (u.job == 0 ? r1 : rmem) + u.pm * 256 + wr * 64 + fr;
#pragma unroll
        for (int ai = 0; ai < 2; ++ai)
#pragma unroll
            for (int m = 0; m < 4; ++m) pre[ai][m] = (u.job == 2) ? 1.0f : rp[ai * 128 + m * 16];
    }
    __device__ __forceinline__ void operator()(const AccT& acc, const pg8::Unit& u, int wr, int wc, int fr, int fq, const float (&pre)[2][4]) const {
        const int rb = u.pm * 256 + wr * 64 + fr;
        if (u.job == 0) {
#pragma unroll
            for (int ai = 0; ai < 2; ++ai)
#pragma unroll
                for (int m = 0; m < 4; ++m) {
                    const int r = rb + ai * 128 + m * 16; const float rs = pre[ai][m];
#pragma unroll
                    for (int bj = 0; bj < 2; ++bj) {
                        const int c = u.pn * 256 + bj * 128 + wc * 32 + fq * 8;
                        f32x4 v0 = acc[ai][bj][m][0] * rs, v1 = acc[ai][bj][m][1] * rs;
                        if (u.pn < 4) { const int g = c >> 4, p0 = c & 15; st_bf16x8(U + ((size_t)g * MT + r) * 16 + p0, v0, v1); }
                        else if (u.pn < 16) {
                            if (u.pn < 6) { v0 = v0 * 0.08838834764831845f; v1 = v1 * 0.08838834764831845f; }
                            if (u.pn >= 12) {
#pragma unroll
                                for (int j = 0; j < 4; ++j) { v0[j] = v0[j] * sigmoid1(v0[j]); v1[j] = v1[j] * sigmoid1(v1[j]); } }
                            st_bf16x8(PROJ + (size_t)r * 3072 + (c - 1024), v0, v1);
                        } else { if (c < 4096 + 16) { *(f32x4*)(GLOW + (size_t)r * 16 + (c - 4096)) = v0; *(f32x4*)(GLOW + (size_t)r * 16 + (c - 4096) + 4) = v1; } }
                    }
                }
        } else if (u.job == 1) {
#pragma unroll
            for (int ai = 0; ai < 2; ++ai)
#pragma unroll
                for (int m = 0; m < 4; ++m) {
                    const int r = rb + ai * 128 + m * 16; const float rs = pre[ai][m];
#pragma unroll
                    for (int bj = 0; bj < 2; ++bj) {
                        const int c = u.pn * 256 + bj * 128 + wc * 32 + fq * 8;
                        const f32x4 v0 = acc[ai][bj][m][0] * rs, v1 = acc[ai][bj][m][1] * rs;
                        if (c < 2048) { float* o = out + O_MK + (size_t)r * 2048 + c; __builtin_nontemporal_store(v0, (f32x4*)o); __builtin_nontemporal_store(v1, (f32x4*)(o + 4)); st_bf16x8(MKB + (size_t)r * 2048 + c, v0, v1); }
                        else { float* o = out + O_MV + (size_t)r * 2048 + (c - 2048); __builtin_nontemporal_store(v0, (f32x4*)o); __builtin_nontemporal_store(v1, (f32x4*)(o + 4)); }
                    }
                }
        } else {
#pragma unroll
            for (int bj = 0; bj < 2; ++bj) {
                const int c = u.pn * 256 + bj * 128 + wc * 32 + fq * 8;
                const f32x4 s0 = *(const f32x4*)(rmem + c), s1 = *(const f32x4*)(rmem + c + 4);
#pragma unroll
                for (int ai = 0; ai < 2; ++ai)
#pragma unroll
                    for (int m = 0; m < 4; ++m) { const int r = rb + ai * 128 + m * 16; st_bf16x8(MVT + (size_t)r * 1024 + c, acc[ai][bj][m][0] * s0, acc[ai][bj][m][1] * s1); }
            }
        }
    }
};

template <bool BB> struct EpiRes {
    const void* baseP; const void* baseS; float* XF; bf16_t* XBo; float* SS; const float* RS; float* SLAB; int nsl;
    __device__ __forceinline__ void prefetch(const pg8::Unit& u, int wr, int fr, float (&pre)[2][4]) const {
#pragma unroll
        for (int ai = 0; ai < 2; ++ai)
#pragma unroll
            for (int m = 0; m < 4; ++m) pre[ai][m] = 1.0f;
    }
    __device__ __forceinline__ void operator()(const AccT& acc, const pg8::Unit& u, int wr, int wc, int fr, int fq, const float (&pre)[2][4]) const {
        if (u.job == 1) { slab_store(acc, u, SLAB, nsl, wr, wc, fr, fq); return; }
        const int rb = u.pm * 256 + wr * 64 + fr;
        const float* basef = (u.pm < 32) ? (const float*)baseP : ((const float*)baseS - (size_t)NPR * DM);
        const bf16_t* baseb = (const bf16_t*)baseP;
        const int c0 = u.pn * 256 + wc * 32 + fq * 8;
        float scl[2][4];
#pragma unroll
        for (int ai = 0; ai < 2; ++ai)
#pragma unroll
            for (int m = 0; m < 4; ++m) scl[ai][m] = RS ? RS[rb + ai * 128 + m * 16] : 1.0f;
        constexpr int MG = BB ? 4 : 2;
#pragma unroll
        for (int ai = 0; ai < 2; ++ai)
#pragma unroll
            for (int mb = 0; mb < 4; mb += MG) {
                u32x4 preb[MG][2]; f32x4 pref[MG][2][2];
#pragma unroll
                for (int mm = 0; mm < MG; ++mm)
#pragma unroll
                    for (int bj = 0; bj < 2; ++bj) {
                        const size_t off = (size_t)(rb + ai * 128 + (mb + mm) * 16) * DM + c0 + bj * 128;
                        if (BB) preb[mm][bj] = *(const u32x4*)(baseb + off);
                        else { pref[mm][bj][0] = __builtin_nontemporal_load((const f32x4*)(basef + off)); pref[mm][bj][1] = __builtin_nontemporal_load((const f32x4*)(basef + off + 4)); }
                    }
#pragma unroll
                for (int mm = 0; mm < MG; ++mm) {
                    const int m = mb + mm, r = rb + ai * 128 + m * 16; float ss = 0.f; const float sc = scl[ai][m];
#pragma unroll
                    for (int bj = 0; bj < 2; ++bj) {
                        const size_t off = (size_t)r * DM + c0 + bj * 128;
                        f32x4 b0, b1;
                        if (BB) { const u32x4 w = preb[mm][bj]; b0 = (f32x4){bflo(w.x), bfhi(w.x), bflo(w.y), bfhi(w.y)}; b1 = (f32x4){bflo(w.z), bfhi(w.z), bflo(w.w), bfhi(w.w)}; }
                        else { b0 = pref[mm][bj][0]; b1 = pref[mm][bj][1]; }
                        const f32x4 v0 = b0 + acc[ai][bj][m][0] * sc, v1 = b1 + acc[ai][bj][m][1] * sc;
                        if (XF) { *(f32x4*)(XF + off) = v0; *(f32x4*)(XF + off + 4) = v1; }
                        if (XBo) st_bf16x8(XBo + off, v0, v1);
                        ss += (v0[0] * v0[0] + v0[1] * v0[1]) + (v0[2] * v0[2] + v0[3] * v0[3]) + (v1[0] * v1[0] + v1[1] * v1[1]) + (v1[2] * v1[2] + v1[3] * v1[3]);
                    }
                    ss += __shfl_xor(ss, 16); ss += __shfl_xor(ss, 32);
                    if (fq == 0) SS[(size_t)r * 32 + u.pn * 4 + wc] = ss;
                }
                asm volatile("" ::: "memory");
            }
    }
};
struct EpiScale {
    const float* RR; bf16_t* O; float scale; float* SLAB; int nsl;
    __device__ __forceinline__ void prefetch(const pg8::Unit& u, int wr, int fr, float (&pre)[2][4]) const {
#pragma unroll
        for (int ai = 0; ai < 2; ++ai)
#pragma unroll
            for (int m = 0; m < 4; ++m) pre[ai][m] = (u.job == 0) ? RR[u.pm * 256 + wr * 64 + fr + ai * 128 + m * 16] : 1.0f;
    }
    __device__ __forceinline__ void operator()(const AccT& acc, const pg8::Unit& u, int wr, int wc, int fr, int fq, const float (&rs)[2][4]) const {
        if (u.job == 1) { slab_store(acc, u, SLAB, nsl, wr, wc, fr, fq); return; }
        const int rb = u.pm * 256 + wr * 64 + fr;
#pragma unroll
        for (int ai = 0; ai < 2; ++ai)
#pragma unroll
            for (int m = 0; m < 4; ++m) { const int r = rb + ai * 128 + m * 16; const float s = rs[ai][m] * scale;
#pragma unroll
                for (int bj = 0; bj < 2; ++bj) { const int c = u.pn * 256 + bj * 128 + wc * 32 + fq * 8; st_bf16x8(O + (size_t)r * DM + c, acc[ai][bj][m][0] * s, acc[ai][bj][m][1] * s); } }
    }
};
__device__ __forceinline__ f32x4 dpp_shr1(f32x4 v) { f32x4 r;
#pragma unroll
    for (int i = 0; i < 4; ++i) r[i] = __int_as_float(__builtin_amdgcn_update_dpp(0, __float_as_int(v[i]), 0x111, 0xf, 0xf, false)); return r; }
__device__ __forceinline__ f32x4 dpp_shr2(f32x4 v) { f32x4 r;
#pragma unroll
    for (int i = 0; i < 4; ++i) r[i] = __int_as_float(__builtin_amdgcn_update_dpp(0, __float_as_int(v[i]), 0x112, 0xf, 0xf, false)); return r; }
__device__ __forceinline__ f32x4 gelu4(f32x4 v) { return (f32x4){gelu1(v[0]), gelu1(v[1]), gelu1(v[2]), gelu1(v[3])}; }
struct EpiUp {
    const float* RR; bf16_t* ACT; float* out; const float* cw; const float* cb; const float* sc; float* HAL; float* HFA; float* HFG;
    __device__ __forceinline__ void prefetch(const pg8::Unit&, int, int, float (&)[2][4]) const {}
    __device__ __forceinline__ void operator()(const AccT& acc, const pg8::Unit& u, int wr, int wc, int fr, int fq, const float (&)[2][4]) const {
        float rs[2][4];
#pragma unroll
        for (int ai = 0; ai < 2; ++ai)
#pragma unroll
            for (int m = 0; m < 4; ++m) rs[ai][m] = RR[u.pm * 256 + wr * 64 + fr + ai * 128 + m * 16];
        float* EX = (float*)(smem + QPRE_OFF);
        int cl = wc * 32 + fq * 8; asm volatile("" : "+v"(cl));
        const int rb = u.pm * 256 + wr * 64 + fr, c = u.pn * 128 + cl;
        const bool sample = (u.pm >= 32);
#pragma unroll
        for (int ai = 0; ai < 2; ++ai)
#pragma unroll
            for (int m = 0; m < 4; ++m) if (fr >= 14) { float* e = EX + (((ai * 8 + wr * 4 + m) * 2 + (fr - 14)) * 128 + cl); *(f32x4*)e = acc[ai][0][m][0] * rs[ai][m]; *(f32x4*)(e + 4) = acc[ai][0][m][1] * rs[ai][m]; }
        float* WT = (float*)(smem + 131072);
        { const int t_ = threadIdx.x; if (t_ < 512) { const int k = t_ >> 7, cc_ = t_ & 127; WT[t_] = (k < 3) ? cw[(size_t)k * DFF + u.pn * 128 + cc_] : cb[u.pn * 128 + cc_]; } }
        asm volatile("s_waitcnt lgkmcnt(0)" ::: "memory"); __builtin_amdgcn_s_barrier(); asm volatile("" ::: "memory");
#pragma unroll
        for (int ai = 0; ai < 2; ++ai)
#pragma unroll
            for (int m = 0; m < 4; ++m) {
                const int r = rb + ai * 128 + m * 16, blk = ai * 8 + wr * 4 + m; const float s = rs[ai][m];
                const f32x4 a0 = acc[ai][0][m][0] * s, a1 = acc[ai][0][m][1] * s, g0 = acc[ai][1][m][0] * s, g1 = acc[ai][1][m][1] * s;
                f32x4 p1a = dpp_shr1(a0), p1b = dpp_shr1(a1), p2a = dpp_shr2(a0), p2b = dpp_shr2(a1);
                bool deferred = false;
                if (!sample) {
                    if (fr < 2) {
                        if (blk > 0) {
                            const float* e = EX + ((blk - 1) * 2) * 128 + cl;
                            const f32x4 x14a = *(const f32x4*)e, x14b = *(const f32x4*)(e + 4), x15a = *(const f32x4*)(e + 128), x15b = *(const f32x4*)(e + 132);
                            if (fr == 0) { p1a = x15a; p1b = x15b; p2a = x14a; p2b = x14b; } else { p2a = x15a; p2b = x15b; }
                        } else if ((u.pm & 7) == 0) {
                            const f32x4 z = (f32x4){0.f, 0.f, 0.f, 0.f};
                            if (fr == 0) { p1a = z; p1b = z; } p2a = z; p2b = z;
                        } else deferred = true;
                    }
                } else {
                    const int j = fr & 3;
                    if (j < 2) { const float* sb = sc + (size_t)((r - NPR) >> 2) * 2 * DFF + c;
                        const f32x4 b1a = *(const f32x4*)(sb + DFF), b1b = *(const f32x4*)(sb + DFF + 4);
                        if (j == 0) { p2a = *(const f32x4*)sb; p2b = *(const f32x4*)(sb + 4); p1a = b1a; p1b = b1b; } else { p2a = b1a; p2b = b1b; } }
                }
                if (!deferred) {
                    u32x4 ow;
                    { const f32x4 w0a = *(const f32x4*)(WT + cl), w1a = *(const f32x4*)(WT + 128 + cl), w2a = *(const f32x4*)(WT + 256 + cl), cba = *(const f32x4*)(WT + 384 + cl);
                      const f32x4 o0 = gelu4(cba + p2a * w0a + p1a * w1a + a0 * w2a) * g0; ow.x = cvt_pk_bf16(o0[0], o0[1]); ow.y = cvt_pk_bf16(o0[2], o0[3]); }
                    asm volatile("" : "+v"(ow.x), "+v"(ow.y));
                    { const f32x4 w0b = *(const f32x4*)(WT + cl + 4), w1b = *(const f32x4*)(WT + 128 + cl + 4), w2b = *(const f32x4*)(WT + 256 + cl + 4), cbb = *(const f32x4*)(WT + 384 + cl + 4);
                      const f32x4 o1 = gelu4(cbb + p2b * w0b + p1b * w1b + a1 * w2b) * g1; ow.z = cvt_pk_bf16(o1[0], o1[1]); ow.w = cvt_pk_bf16(o1[2], o1[3]); }
                    __builtin_nontemporal_store(ow, (u32x4*)(ACT + (size_t)r * DFF + c));
                } else {
                    float* pa = HFA + ((size_t)u.pm * 2 + fr) * DFF + c; float* pg = HFG + ((size_t)u.pm * 2 + fr) * DFF + c;
                    *(f32x4*)pa = a0; *(f32x4*)(pa + 4) = a1; *(f32x4*)pg = g0; *(f32x4*)(pg + 4) = g1;
                }
                if (!sample && blk == 15 && fr >= 14) { float* ph = HAL + ((size_t)u.pm * 2 + (fr - 14)) * DFF + c; *(f32x4*)ph = a0; *(f32x4*)(ph + 4) = a1; }
                if (r < NPR) { const int t = r & 2047; if (t >= 2046) { float* o = out + O_CONV_P + ((size_t)(r >> 11) * 2 + (t - 2046)) * DFF + c; *(f32x4*)o = a0; *(f32x4*)(o + 4) = a1; } }
                else { const int rsm = r - NPR, j = rsm & 3; if (j >= 2) { float* o = out + O_CONV_S + ((size_t)(rsm >> 2) * 2 + (j - 2)) * DFF + c; *(f32x4*)o = a0; *(f32x4*)(o + 4) = a1; } }
                asm volatile("" ::: "memory");
            }
    }
};

#define XB_TMO      128
#define XB_XCNT(j)  (256  + 64 * (j))
#define XB_XSUB(j)  (1280 + 64 * (j))
#define XB_XGEN(j)  (2304 + 64 * (j))
#define XB_TOP      3328
#define XB_TOPGEN   3392
#define XCD_BAR_WORDS 3456
#define XB_SPIN_CAP (1u << 18)
__device__ __forceinline__ unsigned xb_ld(unsigned* p)              { return __hip_atomic_load(p, __ATOMIC_RELAXED, __HIP_MEMORY_SCOPE_AGENT); }
__device__ __forceinline__ unsigned xb_add(unsigned* p, unsigned v) { return __hip_atomic_fetch_add(p, v, __ATOMIC_RELAXED, __HIP_MEMORY_SCOPE_AGENT); }
__device__ __forceinline__ unsigned xb_xcc_id() { return (unsigned)__builtin_amdgcn_s_getreg((3 << 11) | 20) & 0xFu; }
#define XB_SPIN(cond, bar) do { unsigned _sp = 0; while (cond) { __builtin_amdgcn_s_sleep(1); \
    if ((++_sp & 255u) == 0u) { if (xb_ld(&(bar)[XB_TMO])) break; if (_sp > XB_SPIN_CAP) { atomicAdd(&(bar)[XB_TMO], 1u); break; } } } } while (0)
struct XcdBarrier { unsigned* bar; unsigned x; volatile LAS unsigned* st; };
__device__ __forceinline__ XcdBarrier xcd_barrier_post(unsigned* bar, volatile LAS unsigned* st) {
    XcdBarrier b; b.bar = bar; b.x = xb_xcc_id(); b.st = st;
    if (threadIdx.x == 0) (void)xb_add(&bar[XB_XCNT(b.x)], 1u);
    return b;
}
__device__ __forceinline__ void xcd_barrier_complete(unsigned* bar, unsigned x, unsigned& nloc, unsigned& nx) {
    const unsigned G = gridDim.x * gridDim.y * gridDim.z;
    unsigned sum, cnt, mine, sp = 0u;
    for (;;) {
        sum = 0u; cnt = 0u; mine = 0u;
#pragma unroll
        for (unsigned j = 0; j < 16; ++j) { const unsigned c = xb_ld(&bar[XB_XCNT(j)]); sum += c; cnt += (c > 0u) ? 1u : 0u; mine = (j == x) ? c : mine; }
        if (sum == G) break;
        __builtin_amdgcn_s_sleep(1);
        if ((++sp & 255u) == 0u) { if (xb_ld(&bar[XB_TMO])) break; if (sp > XB_SPIN_CAP) { atomicAdd(&bar[XB_TMO], 1u); break; } }
    }
    nloc = mine > 0u ? mine : 1u; nx = cnt > 0u ? cnt : 1u;
}
__device__ __forceinline__ void xcd_barrier(const XcdBarrier& b) {
    asm volatile("s_waitcnt vmcnt(0)" ::: "memory");
    __syncthreads();
    if (threadIdx.x == 0) {
        unsigned* bar = b.bar;
        __builtin_amdgcn_s_waitcnt(0);
        unsigned nloc = b.st[0], nx = b.st[1];
        if (nloc == 0u) { xcd_barrier_complete(bar, b.x, nloc, nx); b.st[0] = nloc; b.st[1] = nx; }
        const unsigned old = xb_add(&bar[XB_XSUB(b.x)], 1u);
        const unsigned gen = old / nloc;
        if (old + 1u == (gen + 1u) * nloc) {
            __builtin_amdgcn_fence(__ATOMIC_RELEASE, "agent");
            asm volatile("s_waitcnt vmcnt(0)" ::: "memory");
            const unsigned og = xb_add(&bar[XB_TOP], 1u);
            const unsigned tg = og / nx;
            if (og + 1u == (tg + 1u) * nx) xb_add(&bar[XB_TOPGEN], 1u);
            else XB_SPIN(xb_ld(&bar[XB_TOPGEN]) == tg, bar);
            __builtin_amdgcn_fence(__ATOMIC_ACQUIRE, "agent");
            xb_add(&bar[XB_XGEN(b.x)], 1u);
            asm volatile("s_waitcnt vmcnt(0)" ::: "memory");
        } else {
            XB_SPIN(xb_ld(&bar[XB_XGEN(b.x)]) == gen, bar);
            __builtin_amdgcn_fence(__ATOMIC_ACQUIRE, "agent");
            asm volatile("s_waitcnt vmcnt(0)" ::: "memory");
        }
    }
    __syncthreads();
}

extern __shared__ __attribute__((aligned(16))) unsigned char smem[];
#define LDS_WAIT() asm volatile("s_waitcnt lgkmcnt(0)" ::: "memory")

__device__ __forceinline__ int rowmap(int mat, int n) {
    if (mat == 0) return n < 3072 ? n : (n < 3088 ? 4096 + (n - 3072) : n - 16);
    if (mat == 6) { if (n < DFF) return (n >> 7) * 256 + (n & 127); const int q = n - DFF; return (q >> 7) * 256 + 128 + (q & 127); }
    return n;
}
__device__ __forceinline__ void transpose_item(const float* __restrict__ W, int K, int N, const float* __restrict__ gain, int glim, bf16_t* __restrict__ Wt, int mat, float* scr, int item, int lane) {
    const int nblk = (N + 63) / 64, kb = item / nblk, nb = item % nblk, k0 = 64 * kb, n0 = 64 * nb;
    const int n4 = (lane & 15) * 4; const bool inb = (n0 + n4 < N);
    f32x4 v[16]; float gsc[16];
#pragma unroll
    for (int i = 0; i < 16; ++i) { const int k = 4 * i + (lane >> 4);
        v[i] = inb ? __builtin_nontemporal_load((const f32x4*)(W + (size_t)(k0 + k) * N + n0 + n4)) : (f32x4){0.f, 0.f, 0.f, 0.f};
        gsc[i] = (gain != nullptr && (k0 + k) < glim) ? gain[k0 + k] : 1.0f; }
#pragma unroll
    for (int i = 0; i < 16; ++i) { const int k = 4 * i + (lane >> 4); float* s = scr + k * 65 + n4; s[0] = v[i][0] * gsc[i]; s[1] = v[i][1] * gsc[i]; s[2] = v[i][2] * gsc[i]; s[3] = v[i][3] * gsc[i]; }
    LDS_WAIT(); asm volatile("" ::: "memory");
#pragma unroll
    for (int j = 0; j < 8; ++j) {
        const int idx = lane + 64 * j, n = idx >> 3, c = idx & 7; const float* s = scr + (8 * c) * 65 + n;
        u32x4 o; o.x = cvt_pk_bf16(s[0], s[65]); o.y = cvt_pk_bf16(s[130], s[195]); o.z = cvt_pk_bf16(s[260], s[325]); o.w = cvt_pk_bf16(s[390], s[455]);
        if (n0 + n < N) *(u32x4*)(Wt + (size_t)rowmap(mat, n0 + n) * K + k0 + 8 * c) = o;
    }
    LDS_WAIT(); asm volatile("" ::: "memory");
}
__device__ __forceinline__ void row_to_bf16(const float* __restrict__ xrow, bf16_t* __restrict__ orow, float* rout, int lane) {
    f32x4 v[8]; float s = 0.f;
#pragma unroll
    for (int j = 0; j < 8; ++j) { v[j] = __builtin_nontemporal_load((const f32x4*)xrow + lane + 64 * j); s += (v[j][0] * v[j][0] + v[j][1] * v[j][1]) + (v[j][2] * v[j][2] + v[j][3] * v[j][3]); }
    s = wave_sum(s);
    if (lane == 0) *rout = rsqrtf(s * (1.0f / 2048.0f) + EPS);
#pragma unroll
    for (int j = 0; j < 8; ++j) { u32x2 w; w.x = cvt_pk_bf16(v[j][0], v[j][1]); w.y = cvt_pk_bf16(v[j][2], v[j][3]); ((u32x2*)orow)[lane + 64 * j] = w; }
}
__device__ __forceinline__ void s5_tables(const Args& a, int g, int part, int tid) {
    float* L = (float*)smem; float* PWR = L; float* PWI = L + 1088; float* BBR = L + 2176; float* BBI = BBR + 1024; float* CR = BBI + 1024; float* CI = CR + 1024;
    unsigned char* ws = a.ws;
    bf16_t* KT = (bf16_t*)(ws + WS_KT) + (size_t)g * 4096; bf16_t* M2T = (bf16_t*)(ws + WS_M2T) + (size_t)g * 32768; bf16_t* M3T = (bf16_t*)(ws + WS_M3T) + (size_t)g * 32768;
    float* A16 = (float*)(ws + WS_A16); float* A4 = (float*)(ws + WS_A4);
    const float dt = expf(a.in[13][g]);
    if (tid < 64) {
        const int n = tid; const float lr = a.in[11][g * 64 + n], li = a.in[12][g * 64 + n];
        const float mag = expf(lr * dt), ar = mag * cosf(li * dt), ai = mag * sinf(li * dt);
        const float den = lr * lr + li * li, pr = ar - 1.0f, qr = (pr * lr + ai * li) / den, qi = (ai * lr - pr * li) / den;
        float cr_ = 1.f, ci_ = 0.f;
        for (int d = 0; d <= 16; ++d) { PWR[d * 64 + n] = cr_; PWI[d * 64 + n] = ci_;
            if (part == 0 && d == 4) { A4[(g * 64 + n) * 2] = cr_; A4[(g * 64 + n) * 2 + 1] = ci_; }
            if (part == 0 && d == 16) { A16[(g * 64 + n) * 2] = cr_; A16[(g * 64 + n) * 2 + 1] = ci_; }
            const float t_ = cr_ * ar - ci_ * ai; ci_ = cr_ * ai + ci_ * ar; cr_ = t_; }
        for (int p = 0; p < 16; ++p) { const float br = a.in[14][(g * 64 + n) * 16 + p], bi = a.in[15][(g * 64 + n) * 16 + p]; BBR[n * 16 + p] = qr * br - qi * bi; BBI[n * 16 + p] = qr * bi + qi * br; }
    }
    for (int i = tid; i < 1024; i += 512) { CR[i] = a.in[16][g * 1024 + i]; CI[i] = a.in[17][g * 1024 + i]; }
    __syncthreads();
    if (part == 0 || part == 3) {
        for (int e = (part == 0 ? 0 : 2048) + tid; e < (part == 0 ? 2048 : 4096); e += 512) {
            const int d = e >> 8, p = (e >> 4) & 15, q = e & 15; float s = 0.f;
            for (int n = 0; n < 64; ++n) { const float pwr = PWR[d * 64 + n], pwi = PWI[d * 64 + n], bbr = BBR[n * 16 + q], bbi = BBI[n * 16 + q];
                const float er = pwr * bbr - pwi * bbi, ei = pwr * bbi + pwi * bbr; s += CR[p * 64 + n] * er - CI[p * 64 + n] * ei; }
            if (d == 0 && p == q) s += a.in[18][g * 16 + p];
            KT[e] = f2bf(s);
        }
    } else if (part == 1) {
        for (int it = tid; it < 4096; it += 512) {
            const int np = it >> 5, s_ = (it >> 1) & 15, q0 = (it & 1) * 8, n = np & 63, d = 15 - s_;
            const float pwr = PWR[d * 64 + n], pwi = PWI[d * 64 + n]; float o[8];
#pragma unroll
            for (int j = 0; j < 8; ++j) { const float bbr = BBR[n * 16 + q0 + j], bbi = BBI[n * 16 + q0 + j]; o[j] = np < 64 ? (pwr * bbr - pwi * bbi) : (pwr * bbi + pwi * bbr); }
            *(u32x4*)(M2T + (size_t)np * 256 + s_ * 16 + q0) = (u32x4){cvt_pk_bf16(o[0], o[1]), cvt_pk_bf16(o[2], o[3]), cvt_pk_bf16(o[4], o[5]), cvt_pk_bf16(o[6], o[7])};
        }
    } else {
        for (int it = tid; it < 4096; it += 512) {
            const int row = it >> 4, np0 = (it & 15) * 8, p = row >> 4, t = row & 15; float o[8];
#pragma unroll
            for (int j = 0; j < 8; ++j) { const int np = np0 + j, n = np & 63; const float ar = PWR[(t + 1) * 64 + n], ai = PWI[(t + 1) * 64 + n], cr = CR[p * 64 + n], ci = CI[p * 64 + n];
                o[j] = np < 64 ? (cr * ar - ci * ai) : -(cr * ai + ci * ar); }
            *(u32x4*)(M3T + (size_t)row * 128 + np0) = (u32x4){cvt_pk_bf16(o[0], o[1]), cvt_pk_bf16(o[2], o[3]), cvt_pk_bf16(o[4], o[5]), cvt_pk_bf16(o[6], o[7])};
        }
    }
    __syncthreads();
}
constexpr int TR_I0 = 32 * 65, TR_ISQ = 32 * 32, TR_I6 = 32 * 176, TR_I7 = 88 * 32;
constexpr int TR_NITEMS = TR_I0 + 5 * TR_ISQ + TR_I6 + TR_I7, TR_DEFER = TR_I7 + TR_I6;
__device__ __forceinline__ void transpose_dispatch(const Args& a, int it, float* scr, int lane) {
    unsigned char* ws = a.ws; bf16_t* WIN = (bf16_t*)(ws + WS_WIN); bf16_t* WXKV = (bf16_t*)(ws + WS_WXKV);
    int r = it;
    if (r < TR_I0) { transpose_item(a.in[10], 2048, 4112, a.in[9], 2048, WIN, 0, scr, r, lane); return; } r -= TR_I0;
    if (r < TR_ISQ) { transpose_item(a.in[25], 2048, 2048, a.in[21], 1024, (bf16_t*)(ws + WS_WOUT), 1, scr, r, lane); return; } r -= TR_ISQ;
    if (r < TR_ISQ) { transpose_item(a.in[28], 2048, 2048, a.in[26], 2048, (bf16_t*)(ws + WS_WXQ), 2, scr, r, lane); return; } r -= TR_ISQ;
    if (r < TR_ISQ) { transpose_item(a.in[29], 2048, 2048, a.in[27], 2048, WXKV, 3, scr, r, lane); return; } r -= TR_ISQ;
    if (r < TR_ISQ) { transpose_item(a.in[30], 2048, 2048, a.in[27], 2048, WXKV + (size_t)2048 * 2048, 4, scr, r, lane); return; } r -= TR_ISQ;
    if (r < TR_ISQ) { transpose_item(a.in[31], 2048, 2048, nullptr, 0, (bf16_t*)(ws + WS_WXO), 5, scr, r, lane); return; } r -= TR_ISQ;
    if (r < TR_I6) { transpose_item(a.in[33], 2048, 11264, a.in[32], 2048, (bf16_t*)(ws + WS_WUP), 6, scr, r, lane); return; } r -= TR_I6;
    transpose_item(a.in[36], 5632, 2048, nullptr, 0, (bf16_t*)(ws + WS_WDN), 7, scr, r, lane);
}
__device__ __forceinline__ void p0_prologue(const Args& a, int bx, int G, int tid, int wave, int lane) {
    unsigned char* ws = a.ws;
    float* scr = (float*)smem + wave * 4160;
    const int gw = bx * NWAVES + wave, NGW = G * NWAVES; bf16_t* WIN = (bf16_t*)(ws + WS_WIN);
    for (int it = gw; it < TR_NITEMS - TR_DEFER; it += NGW) transpose_dispatch(a, it, scr, lane);
    { u32x4* z = (u32x4*)(WIN + (size_t)4112 * 2048); const int nz = 240 * 2048 / 8;
      for (int i = bx * 512 + tid; i < nz; i += G * 512) z[i] = (u32x4){0u, 0u, 0u, 0u}; }
    bf16_t* XB = (bf16_t*)(ws + WS_XB); bf16_t* MEMB = (bf16_t*)(ws + WS_MEMB); float* R1 = (float*)(ws + WS_R1); float* RMEM = (float*)(ws + WS_RMEM);
    for (int m = gw; m < MT + NMEMR; m += NGW) {
        if (m < NPR) row_to_bf16(a.in[0] + (size_t)m * DM, XB + (size_t)m * DM, R1 + m, lane);
        else if (m < MT) row_to_bf16(a.in[1] + (size_t)(m - NPR) * DM, XB + (size_t)m * DM, R1 + m, lane);
        else row_to_bf16(a.in[2] + (size_t)(m - MT) * DM, MEMB + (size_t)(m - MT) * DM, RMEM + (m - MT), lane);
    }
    __syncthreads();
    for (int t = bx; t < 256; t += G) s5_tables(a, t & 63, t >> 6, tid);
}

__device__ __forceinline__ float gelu_v(float v) { return gelu1(v); }
__device__ __forceinline__ f32x4 gelu_v(f32x4 v) { return (f32x4){gelu1(v[0]), gelu1(v[1]), gelu1(v[2]), gelu1(v[3])}; }
__device__ __forceinline__ float sigm_v(float v) { return sigmoid1(v); }
__device__ __forceinline__ f32x4 sigm_v(f32x4 v) { return (f32x4){sigmoid1(v[0]), sigmoid1(v[1]), sigmoid1(v[2]), sigmoid1(v[3])}; }
__device__ __forceinline__ float vget(float v, int) { return v; }
__device__ __forceinline__ float vget(f32x4 v, int i) { return v[i]; }
template <class T, int NV>
__device__ __forceinline__ void s5_glu(T (&y)[16], const float* WL, unsigned (&pk)[NV][8], T& ss) {
#pragma unroll
    for (int p = 0; p < 16; ++p) y[p] = gelu_v(y[p]);
    ss = y[0] * 0.f;
    T prev = ss;
#pragma unroll
    for (int q = 0; q < 16; ++q) {
        T gq = ss * 0.f + WL[256 + q];
#pragma unroll
        for (int p = 0; p < 16; ++p) gq += y[p] * WL[p * 16 + q];
        const T o = y[q] * sigm_v(gq); ss += o * o;
        if (q & 1) {
#pragma unroll
            for (int v = 0; v < NV; ++v) pk[v][q >> 1] = cvt_pk_bf16(vget(prev, v), vget(o, v)); }
        prev = o;
        asm volatile("" ::: "memory");
    }
}

__device__ __forceinline__ void s5_prompt_task(const Args& a, int b, int g, int tid, int w, int lane) {
    unsigned char* ws = a.ws; const int fr = lane & 15, fq = lane >> 4;
    bf16_t* MB = (bf16_t*)smem;
    float* Zs = (float*)smem;
    bf16_t* Hp = (bf16_t*)(smem + 69632);
    float* SE = (float*)(smem + 104448);
    float* WL = (float*)(smem + 108544);
    bf16_t* KL = (bf16_t*)(smem + 109632);
    const bf16_t* Ubg = (const bf16_t*)(ws + WS_U) + ((size_t)g * MT + (size_t)b * 2048) * 16;
    const bf16_t* M2 = (const bf16_t*)(ws + WS_M2T) + (size_t)g * 32768;
    const bf16_t* M3 = (const bf16_t*)(ws + WS_M3T) + (size_t)g * 32768;
    const bf16_t* KTg = (const bf16_t*)(ws + WS_KT) + (size_t)g * 4096;
    if (tid < 256) WL[tid] = a.in[19][g * 256 + tid]; else if (tid < 272) WL[tid] = a.in[20][g * 16 + (tid - 256)];
    {
        u32x4 t[8];
#pragma unroll
        for (int i = 0; i < 8; ++i) t[i] = *(const u32x4*)(M2 + (size_t)(tid + 512 * i) * 8);
        const u32x4 kt = *(const u32x4*)(KTg + tid * 8);
#pragma unroll
        for (int i = 0; i < 8; ++i) { const int idx = tid + 512 * i, rr = idx >> 5, ch = idx & 31; *(u32x4*)(MB + rr * 264 + ch * 8) = t[i]; }
        { const int d = tid >> 5, p = (tid >> 1) & 15, q0 = (tid & 1) * 8; *(u32x4*)(KL + (p * 16 + d) * 16 + q0) = kt; }
    }
    bf16x8 ua[8];
#pragma unroll
    for (int ks = 0; ks < 8; ++ks) ua[ks] = ldg8(Ubg + (size_t)(16 * w + fr) * 256 + 32 * ks + 8 * fq);
    __syncthreads();
    {
        f32x4 acc[8];
#pragma unroll
        for (int nt = 0; nt < 8; ++nt) acc[nt] = (f32x4){0.f, 0.f, 0.f, 0.f};
#pragma unroll
        for (int nt = 0; nt < 8; ++nt)
#pragma unroll
            for (int ks = 0; ks < 8; ++ks) acc[nt] = mma16(*(const bf16x8*)(MB + (16 * nt + fr) * 264 + 32 * ks + 8 * fq), ua[ks], acc[nt]);
        __syncthreads();
#pragma unroll
        for (int nt = 0; nt < 8; ++nt) *(f32x4*)(Zs + (16 * w + fr) * 128 + 16 * nt + 4 * fq) = acc[nt];
    }
    u32x4 m3r[8];
#pragma unroll
    for (int i = 0; i < 8; ++i) m3r[i] = *(const u32x4*)(M3 + (size_t)(tid + 512 * i) * 8);
    __syncthreads();
    {
        const int n = lane, seg = w;
        const float* A16 = (const float*)(ws + WS_A16) + (g * 64 + n) * 2; const float ar = A16[0], ai = A16[1];
        float hr = 0.f, hi = 0.f; float lr[16], li[16];
#pragma unroll
        for (int j = 0; j < 16; ++j) { lr[j] = hr; li[j] = hi; const float zr = Zs[(16 * seg + j) * 128 + n], zi = Zs[(16 * seg + j) * 128 + 64 + n];
            const float t_ = ar * hr - ai * hi + zr; hi = ar * hi + ai * hr + zi; hr = t_; }
        SE[seg * 128 + n] = hr; SE[seg * 128 + 64 + n] = hi;
        __syncthreads();
        float br = ar, bi = ai;
#pragma unroll
        for (int k = 0; k < 4; ++k) { const float t_ = br * br - bi * bi; bi = 2.f * br * bi; br = t_; }
        float cr = 0.f, ci = 0.f;
        for (int s = 0; s < seg; ++s) { const float er = SE[s * 128 + n], ei = SE[s * 128 + 64 + n]; const float t_ = br * cr - bi * ci + er; ci = br * ci + bi * cr + ei; cr = t_; }
        float pr = 1.f, pi = 0.f;
#pragma unroll
        for (int j = 0; j < 16; ++j) { const float Hr = lr[j] + pr * cr - pi * ci, Hi = li[j] + pr * ci + pi * cr;
            Hp[(16 * seg + j) * 136 + n] = f2bf(Hr); Hp[(16 * seg + j) * 136 + 64 + n] = f2bf(Hi);
            const float t_ = pr * ar - pi * ai; pi = pr * ai + pi * ar; pr = t_; }
        if (seg == 7) { float* o = a.out; o[O_S5RE_P + (size_t)(b * 64 + g) * 64 + n] = hr + pr * cr - pi * ci; o[O_S5IM_P + (size_t)(b * 64 + g) * 64 + n] = hi + pr * ci + pi * cr; }
    }
    __syncthreads();
#pragma unroll
    for (int i = 0; i < 8; ++i) { const int idx = tid + 512 * i, rr = idx >> 4, ch = idx & 15; *(u32x4*)(MB + rr * 136 + ch * 8) = m3r[i]; }
    __syncthreads();
    {
        f32x4 acc[16];
#pragma unroll
        for (int p = 0; p < 16; ++p) acc[p] = (f32x4){0.f, 0.f, 0.f, 0.f};
#pragma unroll
        for (int ks = 0; ks < 8; ++ks) {
            const int s = 2 * ks + (fq >> 1), q0 = 8 * (fq & 1), d = fr - s; const int dd = d < 0 ? 0 : d;
#pragma unroll
            for (int p = 0; p < 16; ++p) { bf16x8 bfr = *(const bf16x8*)(KL + (p * 16 + dd) * 16 + q0); if (d < 0) bfr = (bf16x8){0, 0, 0, 0, 0, 0, 0, 0}; acc[p] = mma16(bfr, ua[ks], acc[p]); }
        }
#pragma unroll
        for (int ks = 0; ks < 4; ++ks) {
            const bf16x8 af = *(const bf16x8*)(Hp + (16 * w + fr) * 136 + 32 * ks + 8 * fq);
#pragma unroll
            for (int p = 0; p < 16; ++p) acc[p] = mma16(*(const bf16x8*)(MB + (p * 16 + fr) * 136 + 32 * ks + 8 * fq), af, acc[p]);
        }
        bf16_t* YC = (bf16_t*)(ws + WS_YCAT); float* S5SS = (float*)(ws + WS_S5SS);
        unsigned pk[4][8]; f32x4 ss;
        s5_glu<f32x4, 4>(acc, WL, pk, ss);
#pragma unroll
        for (int r = 0; r < 4; ++r) {
            const size_t row = (size_t)b * 2048 + (size_t)(16 * w + fr) * 16 + 4 * fq + r;
            *(u32x4*)(YC + row * 2048 + g * 16) = (u32x4){pk[r][0], pk[r][1], pk[r][2], pk[r][3]};
            *(u32x4*)(YC + row * 2048 + g * 16 + 8) = (u32x4){pk[r][4], pk[r][5], pk[r][6], pk[r][7]};
            S5SS[row * 64 + g] = ss[r];
        }
    }
    __syncthreads();
}
__device__ __forceinline__ void s5_sample_task(const Args& a, int g, int tid, int w, int lane) {
    unsigned char* ws = a.ws; const int fr = lane & 15, fq = lane >> 4; const int bb = 16 * w + fr;
    const bf16_t* Us = (const bf16_t*)(ws + WS_U) + ((size_t)g * MT + NPR) * 16;
    const bf16_t* M2 = (const bf16_t*)(ws + WS_M2T) + (size_t)g * 32768;
    const bf16_t* M3 = (const bf16_t*)(ws + WS_M3T) + (size_t)g * 32768;
    const bf16_t* KTg = (const bf16_t*)(ws + WS_KT) + (size_t)g * 4096;
    const float* h0r = a.in[5] + ((size_t)bb * 64 + g) * 64; const float* h0i = a.in[6] + ((size_t)bb * 64 + g) * 64;
    float* WL = (float*)smem;
    if (tid < 256) WL[tid] = a.in[19][g * 256 + tid]; else if (tid < 272) WL[tid] = a.in[20][g * 16 + (tid - 256)];
    __syncthreads();
    bf16x8 ua[2], ha[4];
#pragma unroll
    for (int ks = 0; ks < 2; ++ks) ua[ks] = ldg8(Us + (size_t)bb * 64 + 32 * ks + 8 * fq);
#pragma unroll
    for (int ks = 0; ks < 4; ++ks) { const int np = 32 * ks + 8 * fq; const float* src = (np < 64 ? h0r + np : h0i + (np - 64)); ha[ks] = pack8(*(const f32x4*)src, *(const f32x4*)(src + 4)); }
    f32x4 acc[4];
#pragma unroll
    for (int nt = 0; nt < 4; ++nt) acc[nt] = (f32x4){0.f, 0.f, 0.f, 0.f};
    const int tB = fr >> 2, pB = fr & 3;
#pragma unroll
    for (int ks = 0; ks < 2; ++ks) {
        const int s = 2 * ks + (fq >> 1), q0 = 8 * (fq & 1), d = tB - s; const int dd = d < 0 ? 0 : d;
#pragma unroll
        for (int nt = 0; nt < 4; ++nt) { bf16x8 bfr = ldg8(KTg + (dd * 16 + 4 * nt + pB) * 16 + q0); if (d < 0) bfr = (bf16x8){0, 0, 0, 0, 0, 0, 0, 0}; acc[nt] = mma16(bfr, ua[ks], acc[nt]); }
    }
#pragma unroll
    for (int ks = 0; ks < 4; ++ks)
#pragma unroll
        for (int nt = 0; nt < 4; ++nt) acc[nt] = mma16(ldg8(M3 + (size_t)((4 * nt + pB) * 16 + tB) * 128 + 32 * ks + 8 * fq), ha[ks], acc[nt]);
    {
        float y[16];
#pragma unroll
        for (int nt = 0; nt < 4; ++nt)
#pragma unroll
            for (int r = 0; r < 4; ++r) y[4 * nt + r] = acc[nt][r];
        const size_t row = (size_t)NPR + 4 * bb + fq;
        unsigned pk[1][8]; float ss;
        s5_glu<float, 1>(y, WL, pk, ss);
        bf16_t* dst = (bf16_t*)(ws + WS_YCAT) + row * 2048 + g * 16;
        *(u32x4*)dst = (u32x4){pk[0][0], pk[0][1], pk[0][2], pk[0][3]}; *(u32x4*)(dst + 8) = (u32x4){pk[0][4], pk[0][5], pk[0][6], pk[0][7]};
        ((float*)(ws + WS_S5SS))[row * 64 + g] = ss;
    }
    f32x4 ac2[8];
#pragma unroll
    for (int nt = 0; nt < 8; ++nt) ac2[nt] = (f32x4){0.f, 0.f, 0.f, 0.f};
#pragma unroll
    for (int ks = 0; ks < 2; ++ks)
#pragma unroll
        for (int nt = 0; nt < 8; ++nt) ac2[nt] = mma16(ldg8(M2 + (size_t)(16 * nt + fr) * 256 + 192 + 32 * ks + 8 * fq), ua[ks], ac2[nt]);
    const float* A4 = (const float*)(ws + WS_A4) + (size_t)g * 128;
#pragma unroll
    for (int nt = 0; nt < 4; ++nt) {
        const int n0 = 16 * nt + 4 * fq;
        const f32x4 hr = *(const f32x4*)(h0r + n0), hi = *(const f32x4*)(h0i + n0);
        const f32x4 c0 = *(const f32x4*)(A4 + 2 * n0), c1 = *(const f32x4*)(A4 + 2 * n0 + 4);
        const float ar[4] = {c0[0], c0[2], c1[0], c1[2]}, ai[4] = {c0[1], c0[3], c1[1], c1[3]};
        f32x4 orr, oii;
#pragma unroll
        for (int r = 0; r < 4; ++r) { orr[r] = ar[r] * hr[r] - ai[r] * hi[r] + ac2[nt][r]; oii[r] = ar[r] * hi[r] + ai[r] * hr[r] + ac2[nt + 4][r]; }
        *(f32x4*)(a.out + O_S5RE_S + ((size_t)bb * 64 + g) * 64 + n0) = orr;
        *(f32x4*)(a.out + O_S5IM_S + ((size_t)bb * 64 + g) * 64 + n0) = oii;
    }
    __syncthreads();
}

__device__ __forceinline__ void gla_a_task(const Args& a, int task, int tid, int w, int lane) {
    unsigned char* ws = a.ws; const int fr = lane & 15, fq = lane >> 4;
    const int b = task >> 7, h = (task >> 5) & 3, c = task & 31;
    bf16_t* QT = (bf16_t*)smem;
    bf16_t* KTt = (bf16_t*)(smem + 17408);
    bf16_t* KET = (bf16_t*)(smem + 34816);
    bf16_t* VT = (bf16_t*)(smem + 53248);
    bf16_t* PM = (bf16_t*)(smem + 90112);
    float* CS = (float*)(smem + 99328);
    const bf16_t* PROJ = (const bf16_t*)(ws + WS_PROJ); const float* GLOW = (const float*)(ws + WS_GLOW);
    bf16_t* OG = (bf16_t*)(ws + WS_OG); bf16_t* KVC = (bf16_t*)(ws + WS_KVC) + (size_t)task * 32768; bf16_t* QTG = (bf16_t*)(ws + WS_QTG) + (size_t)task * 8192;
    float* DECG = (float*)(ws + WS_DECG) + (size_t)task * 128;
    const int dk = tid & 127, tq = tid >> 7;
    const size_t rowc = (size_t)b * 2048 + (size_t)c * 64;
    bf16_t* RQ = (bf16_t*)(smem + 101376);
    bf16_t* RK = (bf16_t*)(smem + 117760);
    float* GL = (float*)(smem + 134144);
    {
        u32x4 tq_[2], tk_[2]; f32x4 tg = (f32x4){0.f, 0.f, 0.f, 0.f};
#pragma unroll
        for (int i = 0; i < 2; ++i) { const int idx = tid + 512 * i, rr = idx >> 4, ch = idx & 15; const bf16_t* src = PROJ + (rowc + rr) * 3072 + h * 128 + ch * 8; tq_[i] = *(const u32x4*)src; tk_[i] = *(const u32x4*)(src + 512); }
        if (tid < 256) tg = *(const f32x4*)(GLOW + rowc * 16 + tid * 4);
#pragma unroll
        for (int i = 0; i < 2; ++i) { const int idx = tid + 512 * i; *(u32x4*)(RQ + idx * 8) = tq_[i]; *(u32x4*)(RK + idx * 8) = tk_[i]; }
        if (tid < 256) *(f32x4*)(GL + tid * 4) = tg;
    }
    float wg[16];
#pragma unroll
    for (int j = 0; j < 16; ++j) wg[j] = a.in[22][j * 512 + h * 128 + dk];
    const float bg = a.in[23][h * 128 + dk];
    __syncthreads();
    float lcs[16]; float run = 0.f;
#pragma unroll
    for (int i = 0; i < 16; ++i) {
        const float* gl = GL + (16 * tq + i) * 16;
        const f32x4 g0 = *(const f32x4*)gl, g1 = *(const f32x4*)(gl + 4), g2 = *(const f32x4*)(gl + 8), g3 = *(const f32x4*)(gl + 12);
        float z = bg;
#pragma unroll
        for (int j = 0; j < 4; ++j) { z += g0[j] * wg[j]; z += g1[j] * wg[4 + j]; z += g2[j] * wg[8 + j]; z += g3[j] * wg[12 + j]; }
        run += (fminf(z, 0.f) - __logf(1.0f + __expf(-fabsf(z)))) * 0.0625f; lcs[i] = run;
    }
    CS[tq * 128 + dk] = run;
    __syncthreads();
    float pre = 0.f, tot = 0.f;
#pragma unroll
    for (int q = 0; q < 4; ++q) { const float v = CS[q * 128 + dk]; tot += v; if (q < tq) pre += v; }
    {
        unsigned kep[8];
#pragma unroll
        for (int i = 0; i < 16; i += 2) {
            float kes[2];
#pragma unroll
            for (int e = 0; e < 2; ++e) {
                const int t = 16 * tq + i + e; const float bc = pre + lcs[i + e];
                const float qv = bf2f(RQ[t * 128 + dk]), kv = bf2f(RK[t * 128 + dk]);
                QT[t * 136 + dk] = f2bf(qv * __expf(bc)); KTt[t * 136 + dk] = f2bf(kv * __expf(-bc)); kes[e] = kv * __expf(tot - bc);
            }
            kep[i >> 1] = cvt_pk_bf16(kes[0], kes[1]);
        }
        *(u32x4*)(KET + dk * 72 + 16 * tq) = (u32x4){kep[0], kep[1], kep[2], kep[3]};
        *(u32x4*)(KET + dk * 72 + 16 * tq + 8) = (u32x4){kep[4], kep[5], kep[6], kep[7]};
        if (tq == 0) DECG[dk] = __expf(tot);
        const int dv = tid & 255, sh = tid >> 8;
        unsigned vp[16];
#pragma unroll
        for (int i = 0; i < 32; i += 2) {
            const bf16_t v0 = PROJ[(rowc + 32 * sh + i) * 3072 + 1024 + h * 256 + dv], v1 = PROJ[(rowc + 32 * sh + i + 1) * 3072 + 1024 + h * 256 + dv];
            vp[i >> 1] = (unsigned)v0 | ((unsigned)v1 << 16);
        }
#pragma unroll
        for (int i = 0; i < 4; ++i) *(u32x4*)(VT + dv * 72 + 32 * sh + 8 * i) = (u32x4){vp[4 * i], vp[4 * i + 1], vp[4 * i + 2], vp[4 * i + 3]};
    }
    __syncthreads();
    {
#pragma unroll
        for (int i = 0; i < 2; ++i) { const int idx = tid + 512 * i, rr = idx >> 4, ch = idx & 15; *(u32x4*)(QTG + rr * 128 + ch * 8) = *(const u32x4*)(QT + rr * 136 + ch * 8); }
        const int mt = w & 3;
#pragma unroll
        for (int e = 0; e < 2; ++e) {
            const int nt = 2 * (w >> 2) + e; f32x4 sc = (f32x4){0.f, 0.f, 0.f, 0.f};
            if (nt <= mt) {
#pragma unroll
                for (int ks = 0; ks < 4; ++ks) sc = mma16(*(const bf16x8*)(KTt + (16 * nt + fr) * 136 + 32 * ks + 8 * fq), *(const bf16x8*)(QT + (16 * mt + fr) * 136 + 32 * ks + 8 * fq), sc);
                const int t = 16 * mt + fr, s0 = 16 * nt + 4 * fq;
#pragma unroll
                for (int r = 0; r < 4; ++r) if (s0 + r > t) sc[r] = 0.f;
            }
            u32x2 pw; pw.x = cvt_pk_bf16(sc[0], sc[1]); pw.y = cvt_pk_bf16(sc[2], sc[3]);
            *(u32x2*)(PM + (16 * mt + fr) * 72 + 16 * nt + 4 * fq) = pw;
        }
    }
    {
        f32x4 ak[2][8];
#pragma unroll
        for (int e = 0; e < 2; ++e)
#pragma unroll
            for (int nt = 0; nt < 8; ++nt) ak[e][nt] = (f32x4){0.f, 0.f, 0.f, 0.f};
#pragma unroll
        for (int ks = 0; ks < 2; ++ks) {
            const bf16x8 a0 = *(const bf16x8*)(VT + (32 * w + fr) * 72 + 32 * ks + 8 * fq), a1 = *(const bf16x8*)(VT + (32 * w + 16 + fr) * 72 + 32 * ks + 8 * fq);
#pragma unroll
            for (int nt = 0; nt < 8; ++nt) { const bf16x8 bfr = *(const bf16x8*)(KET + (16 * nt + fr) * 72 + 32 * ks + 8 * fq); ak[0][nt] = mma16(bfr, a0, ak[0][nt]); ak[1][nt] = mma16(bfr, a1, ak[1][nt]); }
        }
#pragma unroll
        for (int e = 0; e < 2; ++e)
#pragma unroll
            for (int nt = 0; nt < 8; ++nt) { u32x2 pw; pw.x = cvt_pk_bf16(ak[e][nt][0], ak[e][nt][1]); pw.y = cvt_pk_bf16(ak[e][nt][2], ak[e][nt][3]);
                *(u32x2*)(KVC + (size_t)(32 * w + 16 * e + fr) * 128 + 16 * nt + 4 * fq) = pw; }
    }
    __syncthreads();
    {
        const int mt = w & 3, nt0 = 8 * (w >> 2);
        f32x4 ao[8];
#pragma unroll
        for (int e = 0; e < 8; ++e) ao[e] = (f32x4){0.f, 0.f, 0.f, 0.f};
#pragma unroll
        for (int ks = 0; ks < 2; ++ks) { const bf16x8 af = *(const bf16x8*)(PM + (16 * mt + fr) * 72 + 32 * ks + 8 * fq);
#pragma unroll
            for (int e = 0; e < 8; ++e) ao[e] = mma16(*(const bf16x8*)(VT + (16 * (nt0 + e) + fr) * 72 + 32 * ks + 8 * fq), af, ao[e]); }
        const size_t row = rowc + 16 * mt + fr;
#pragma unroll
        for (int e = 0; e < 8; ++e) { u32x2 pw; pw.x = cvt_pk_bf16(ao[e][0], ao[e][1]); pw.y = cvt_pk_bf16(ao[e][2], ao[e][3]);
            *(u32x2*)(OG + row * 1024 + h * 256 + 16 * (nt0 + e) + 4 * fq) = pw; }
    }
    __syncthreads();
}
__device__ __forceinline__ void gla_b_scan(const Args& a, int bx, int G, int tid) {
    unsigned char* ws = a.ws;
    const bf16_t* KVC = (const bf16_t*)(ws + WS_KVC); bf16_t* SPREV = (bf16_t*)(ws + WS_SPREV); const float* DECG = (const float*)(ws + WS_DECG);
    for (int gid = bx * 512 + tid; gid < 16 * 8192; gid += G * 512) {
        const int bh = gid >> 13, e = gid & 8191, dv = e >> 5, dk0 = (e & 31) * 4;
        f32x4 S = (f32x4){0.f, 0.f, 0.f, 0.f};
#pragma unroll 8
        for (int c = 0; c < 32; ++c) {
            const size_t task = (size_t)bh * 32 + c;
            const u32x2 kv = __builtin_nontemporal_load((const u32x2*)(KVC + task * 32768 + (size_t)e * 4)); const f32x4 dc = *(const f32x4*)(DECG + task * 128 + dk0);
            u32x2 sp; sp.x = cvt_pk_bf16(S[0], S[1]); sp.y = cvt_pk_bf16(S[2], S[3]);
            *(u32x2*)(SPREV + task * 32768 + (size_t)e * 4) = sp;
            S[0] = dc[0] * S[0] + bflo(kv.x); S[1] = dc[1] * S[1] + bfhi(kv.x); S[2] = dc[2] * S[2] + bflo(kv.y); S[3] = dc[3] * S[3] + bfhi(kv.y);
        }
#pragma unroll
        for (int i = 0; i < 4; ++i) a.out[O_GLA_P + ((size_t)bh * 128 + dk0 + i) * 256 + dv] = S[i];
    }
}
__device__ __forceinline__ void gla_c_task(const Args& a, int task, int tid, int w, int lane) {
    unsigned char* ws = a.ws; const int fr = lane & 15, fq = lane >> 4;
    const int b = task >> 7, h = (task >> 5) & 3, c = task & 31;
    float* RED = (float*)smem;
    float* RINV = (float*)(smem + 512);
    const bf16_t* PROJ = (const bf16_t*)(ws + WS_PROJ); const bf16_t* OG = (const bf16_t*)(ws + WS_OG);
    const bf16_t* SPREV = (const bf16_t*)(ws + WS_SPREV) + (size_t)task * 32768; const bf16_t* QTG = (const bf16_t*)(ws + WS_QTG) + (size_t)task * 8192;
    const size_t rowc = (size_t)b * 2048 + (size_t)c * 64;
    if (tid < 64) {
        const float* sp = (const float*)(ws + WS_S5SS) + (rowc + tid) * 64; float s = 0.f;
#pragma unroll
        for (int i = 0; i < 16; ++i) { const f32x4 v = *(const f32x4*)(sp + 4 * i); s += (v[0] + v[1]) + (v[2] + v[3]); }
        const float m = s * (1.0f / 1024.0f) + EPS;
        RINV[tid] = sqrtf(m);
        if (h == 0) ((float*)(ws + WS_RS5))[rowc + tid] = rsqrtf(m);
    }
    const int mt = w & 3, nt0 = 8 * (w >> 2);
    const size_t row = rowc + 16 * mt + fr;
    bf16_t* SPV = (bf16_t*)(smem + 1024);
    bf16_t* QTL = (bf16_t*)(smem + 1024 + 69632);
    {
        u32x4 t[8], tq_[2];
#pragma unroll
        for (int i = 0; i < 8; ++i) t[i] = __builtin_nontemporal_load((const u32x4*)(SPREV + (size_t)(tid + 512 * i) * 8));
#pragma unroll
        for (int i = 0; i < 2; ++i) tq_[i] = *(const u32x4*)(QTG + (size_t)(tid + 512 * i) * 8);
#pragma unroll
        for (int i = 0; i < 8; ++i) { const int idx = tid + 512 * i, rr = idx >> 4, ch = idx & 15; *(u32x4*)(SPV + rr * 136 + ch * 8) = t[i]; }
#pragma unroll
        for (int i = 0; i < 2; ++i) { const int idx = tid + 512 * i, rr = idx >> 4, ch = idx & 15; *(u32x4*)(QTL + rr * 136 + ch * 8) = tq_[i]; }
    }
    f32x4 acc[8];
#pragma unroll
    for (int e = 0; e < 8; ++e) { const u32x2 v = *(const u32x2*)(OG + row * 1024 + h * 256 + 16 * (nt0 + e) + 4 * fq); acc[e] = (f32x4){bflo(v.x), bfhi(v.x), bflo(v.y), bfhi(v.y)}; }
    __syncthreads();
#pragma unroll
    for (int ks = 0; ks < 4; ++ks) { const bf16x8 af = *(const bf16x8*)(QTL + (16 * mt + fr) * 136 + 32 * ks + 8 * fq);
#pragma unroll
        for (int e = 0; e < 8; ++e) acc[e] = mma16(*(const bf16x8*)(SPV + (16 * (nt0 + e) + fr) * 136 + 32 * ks + 8 * fq), af, acc[e]); }
    float ss = 0.f;
#pragma unroll
    for (int e = 0; e < 8; ++e) ss += (acc[e][0] * acc[e][0] + acc[e][1] * acc[e][1]) + (acc[e][2] * acc[e][2] + acc[e][3] * acc[e][3]);
    ss += __shfl_xor(ss, 16); ss += __shfl_xor(ss, 32);
    if (fq == 0) RED[(w >> 2) * 64 + 16 * mt + fr] = ss;
    __syncthreads();
    const float rh = rsqrtf((RED[16 * mt + fr] + RED[64 + 16 * mt + fr]) * (1.0f / 256.0f) + EPS) * RINV[16 * mt + fr];
    const float* ng = a.in[24];
#pragma unroll
    for (int e = 0; e < 8; ++e) {
        const int dv = 16 * (nt0 + e) + 4 * fq;
        const f32x4 g = *(const f32x4*)(ng + dv); const u32x2 rv = *(const u32x2*)(PROJ + row * 3072 + 2048 + h * 256 + dv);
        u32x2 o; o.x = cvt_pk_bf16(acc[e][0] * rh * g[0] * bflo(rv.x), acc[e][1] * rh * g[1] * bfhi(rv.x)); o.y = cvt_pk_bf16(acc[e][2] * rh * g[2] * bflo(rv.y), acc[e][3] * rh * g[3] * bfhi(rv.y));
        *(u32x2*)((bf16_t*)(ws + WS_YCAT) + row * 2048 + 1024 + h * 256 + dv) = o;
    }
    __syncthreads();
}
__device__ __forceinline__ void gla_sample_task(const Args& a, int task, int tid, int w, int lane) {
    unsigned char* ws = a.ws; const int b = task >> 2, h = task & 3;
    f32x4* AKQ = (f32x4*)smem;
    float* ORED = (float*)(smem + 8192);
    float* SSW = (float*)(smem + 40960);
    float* RINV = (float*)(smem + 40960 + 64);
    const bf16_t* PROJ = (const bf16_t*)(ws + WS_PROJ); const float* GLOW = (const float*)(ws + WS_GLOW);
    {
        const int dk = tid & 127, j = tid >> 7; const size_t row = (size_t)NPR + 4 * b + j;
        float z = a.in[23][h * 128 + dk];
#pragma unroll
        for (int q = 0; q < 16; ++q) z += GLOW[row * 16 + q] * a.in[22][q * 512 + h * 128 + dk];
        const float dec = __expf(logsigmoid1(z) * 0.0625f);
        AKQ[j * 128 + dk] = (f32x4){dec, bf2f(PROJ[row * 3072 + 512 + h * 128 + dk]), bf2f(PROJ[row * 3072 + h * 128 + dk]), 0.f};
    }
    const int dv0 = 4 * lane;
    const size_t sbase = ((size_t)(b * 4 + h) * 128 + 16 * w) * 256 + dv0;
    f32x4 S[16];
#pragma unroll
    for (int i = 0; i < 16; ++i) S[i] = __builtin_nontemporal_load((const f32x4*)(a.in[7] + sbase + (size_t)i * 256));
    __syncthreads();
#pragma unroll
    for (int j = 0; j < 4; ++j) {
        const u32x2 vv = *(const u32x2*)(PROJ + ((size_t)NPR + 4 * b + j) * 3072 + 1024 + h * 256 + dv0);
        const f32x4 v = (f32x4){bflo(vv.x), bfhi(vv.x), bflo(vv.y), bfhi(vv.y)}; f32x4 op = (f32x4){0.f, 0.f, 0.f, 0.f};
#pragma unroll
        for (int i = 0; i < 16; ++i) { const f32x4 q = AKQ[j * 128 + 16 * w + i]; S[i] = S[i] * q[0] + v * q[1]; op += S[i] * q[2]; }
        *(f32x4*)(ORED + (w * 4 + j) * 256 + dv0) = op;
    }
#pragma unroll
    for (int i = 0; i < 16; ++i) __builtin_nontemporal_store(S[i], (f32x4*)(a.out + O_GLA_S + sbase + (size_t)i * 256));
    __syncthreads();
    const int j = tid >> 7, dvp = 2 * (tid & 127); const size_t row = (size_t)NPR + 4 * b + j;
    f32x2 o = (f32x2){0.f, 0.f};
#pragma unroll
    for (int gq = 0; gq < 8; ++gq) o += *(const f32x2*)(ORED + (gq * 4 + j) * 256 + dvp);
    { const float ss = wave_sum(o[0] * o[0] + o[1] * o[1]); if (lane == 0) SSW[j * 2 + (w & 1)] = ss; }
    if (w < 4) {
        const size_t rw = (size_t)NPR + 4 * b + w;
        const float sm = wave_sum(((const float*)(ws + WS_S5SS))[rw * 64 + lane]); const float m = sm * (1.0f / 1024.0f) + EPS;
        if (lane == 0) { RINV[w] = sqrtf(m); if (h == 0) ((float*)(ws + WS_RS5))[rw] = rsqrtf(m); }
    }
    __syncthreads();
    {
        const float rh = rsqrtf((SSW[j * 2] + SSW[j * 2 + 1]) * (1.0f / 256.0f) + EPS) * RINV[j];
        const f32x2 g = *(const f32x2*)(a.in[24] + dvp); const unsigned rv = *(const unsigned*)(PROJ + row * 3072 + 2048 + h * 256 + dvp);
        *(unsigned*)((bf16_t*)(ws + WS_YCAT) + row * 2048 + 1024 + h * 256 + dvp) = cvt_pk_bf16(o[0] * rh * g[0] * bflo(rv), o[1] * rh * g[1] * bfhi(rv));
    }
    __syncthreads();
}
__device__ __forceinline__ void attn_prompt_task(const Args& a, int task, int tid, int w, int lane) {
    unsigned char* ws = a.ws; const int fr = lane & 15, fq = lane >> 4;
    const int b = task >> 6, h = (task >> 4) & 3, blk = task & 15;
    bf16_t* KC = (bf16_t*)smem;
    bf16_t* VC = (bf16_t*)(smem + 66560);
    const bf16_t* QX = (const bf16_t*)(ws + WS_QX); const bf16_t* MKB = (const bf16_t*)(ws + WS_MKB); const bf16_t* MVT = (const bf16_t*)(ws + WS_MVT);
    bf16_t* OX = (bf16_t*)(ws + WS_OX);
    const size_t row = (size_t)b * 2048 + blk * 128 + 16 * w + fr;
    f32x4 sacc[16];
#pragma unroll
    for (int nt = 0; nt < 16; ++nt) sacc[nt] = (f32x4){0.f, 0.f, 0.f, 0.f};
    {
        u32x4 kr[8];
#pragma unroll
        for (int it = 0; it < 8; ++it) { const int idx = tid + 512 * it, rr = idx >> 6, ch = idx & 63; kr[it] = *(const u32x4*)(MKB + ((size_t)b * 256 + rr) * 2048 + h * 512 + ch * 8); }
#pragma unroll
        for (int mc = 0; mc < 4; ++mc) {
#pragma unroll
            for (int it = 0; it < 8; ++it) { const int idx = tid + 512 * it, rr = idx >> 6, ch = idx & 63; *(u32x4*)(KC + rr * 520 + ch * 8) = kr[it]; }
            __syncthreads();
            if (mc < 3) {
#pragma unroll
                for (int it = 0; it < 8; ++it) { const int idx = tid + 512 * it, rr = idx >> 6, ch = idx & 63; kr[it] = *(const u32x4*)(MKB + ((size_t)b * 256 + 64 * (mc + 1) + rr) * 2048 + h * 512 + ch * 8); }
            }
#pragma unroll
            for (int ks = 0; ks < 16; ++ks) {
                const bf16x8 aq = ldg8(QX + row * 2048 + h * 512 + 32 * ks + 8 * fq);
#pragma unroll
                for (int ntl = 0; ntl < 4; ++ntl) sacc[4 * mc + ntl] = mma16(*(const bf16x8*)(KC + (16 * ntl + fr) * 520 + 32 * ks + 8 * fq), aq, sacc[4 * mc + ntl]);
                if ((ks & 3) == 3) asm volatile("" ::: "memory");
            }
            __syncthreads();
        }
    }
    u32x4 vr[4];
#pragma unroll
    for (int it = 0; it < 4; ++it) { const int idx = tid + 512 * it, rr = idx >> 3, ch = idx & 7; vr[it] = *(const u32x4*)(MVT + ((size_t)h * 512 + rr) * 1024 + b * 256 + ch * 8); }
    float mx = -3.0e38f;
#pragma unroll
    for (int nt = 0; nt < 16; ++nt) mx = fmaxf(mx, fmaxf(fmaxf(sacc[nt][0], sacc[nt][1]), fmaxf(sacc[nt][2], sacc[nt][3])));
    mx = fmaxf(mx, __shfl_xor(mx, 16)); mx = fmaxf(mx, __shfl_xor(mx, 32));
    float lsum = 0.f;
#pragma unroll
    for (int nt = 0; nt < 16; ++nt)
#pragma unroll
        for (int r = 0; r < 4; ++r) { const float e = __expf(sacc[nt][r] - mx); sacc[nt][r] = e; lsum += e; }
    lsum += __shfl_xor(lsum, 16); lsum += __shfl_xor(lsum, 32);
    const float linv = 1.0f / lsum;
    bf16x8 ap[8];
#pragma unroll
    for (int ks = 0; ks < 8; ++ks) ap[ks] = pack8(sacc[2 * ks], sacc[2 * ks + 1]);
#pragma unroll 1
    for (int dh = 0; dh < 2; ++dh) {
        f32x4 oacc[16];
#pragma unroll
        for (int nt = 0; nt < 16; ++nt) oacc[nt] = (f32x4){0.f, 0.f, 0.f, 0.f};
#pragma unroll
        for (int mc = 0; mc < 4; ++mc) {
#pragma unroll
            for (int it = 0; it < 4; ++it) { const int idx = tid + 512 * it, rr = idx >> 3, ch = idx & 7; *(u32x4*)(VC + rr * 72 + ch * 8) = vr[it]; }
            __syncthreads();
            {
                const int st = dh * 4 + mc + 1;
                if (st < 8) {
                    const int ndh = st >> 2, nmc = st & 3;
#pragma unroll
                    for (int it = 0; it < 4; ++it) { const int idx = tid + 512 * it, rr = idx >> 3, ch = idx & 7; vr[it] = *(const u32x4*)(MVT + ((size_t)h * 512 + ndh * 256 + rr) * 1024 + b * 256 + 64 * nmc + ch * 8); }
                }
            }
#pragma unroll
            for (int ksl = 0; ksl < 2; ++ksl)
#pragma unroll
                for (int nt = 0; nt < 16; ++nt) {
                    const bf16_t* vp = VC + (16 * nt + fr) * 72 + 32 * ksl + 4 * fq;
                    const u32x2 lo = *(const u32x2*)vp, hi = *(const u32x2*)(vp + 16);
                    const u32x4 bw = (u32x4){lo.x, lo.y, hi.x, hi.y};
                    oacc[nt] = mma16(__builtin_bit_cast(bf16x8, bw), ap[2 * mc + ksl], oacc[nt]);
                }
            __syncthreads();
        }
#pragma unroll
        for (int nt = 0; nt < 16; ++nt) { u32x2 pw; pw.x = cvt_pk_bf16(oacc[nt][0] * linv, oacc[nt][1] * linv); pw.y = cvt_pk_bf16(oacc[nt][2] * linv, oacc[nt][3] * linv);
            *(u32x2*)(OX + row * 2048 + h * 512 + dh * 256 + 16 * nt + 4 * fq) = pw; }
    }
}
__device__ __forceinline__ float reduce16(const float (&p)[16], int lane) {
    float a8[8], a4[4], a2[2];
#pragma unroll
    for (int i = 0; i < 8; ++i) { const bool hi = (lane & 32) != 0; const float send = hi ? p[i] : p[i + 8], keep = hi ? p[i + 8] : p[i]; a8[i] = keep + __shfl_xor(send, 32); }
#pragma unroll
    for (int i = 0; i < 4; ++i) { const bool hi = (lane & 16) != 0; const float send = hi ? a8[i] : a8[i + 4], keep = hi ? a8[i + 4] : a8[i]; a4[i] = keep + __shfl_xor(send, 16); }
#pragma unroll
    for (int i = 0; i < 2; ++i) { const bool hi = (lane & 8) != 0; const float send = hi ? a4[i] : a4[i + 2], keep = hi ? a4[i + 2] : a4[i]; a2[i] = keep + __shfl_xor(send, 8); }
    const bool hi = (lane & 4) != 0; const float send = hi ? a2[0] : a2[1], keep = hi ? a2[1] : a2[0];
    float d = keep + __shfl_xor(send, 4);
    d += __shfl_xor(d, 2); d += __shfl_xor(d, 1);
    return d;
}
__device__ __forceinline__ f32x4 attn_q_combine(const Args& a, int task, int tid) {
    unsigned char* ws = a.ws; const int b = task >> 2, h = task & 3;
    const float* SLAB = (const float*)(ws + WS_SLAB); const float* R2 = (const float*)(ws + WS_R2);
    const int j = tid >> 7, c4 = (tid & 127) * 4;
    const int rs = 4 * b + j, pmq = rs >> 8, rr = rs & 255, col = h * 512 + c4, pn = col >> 8, cc = col & 255;
    const float* p = SLAB + (size_t)((pmq * 8 + pn) * 8) * 65536 + (size_t)rr * 256 + cc;
    f32x4 s0 = (f32x4){0.f, 0.f, 0.f, 0.f};
#pragma unroll
    for (int ks = 0; ks < 8; ++ks) s0 += *(const f32x4*)(p + (size_t)ks * 65536);
    return s0 * (R2[NPR + rs] * 0.04419417382415922f);
}
__device__ __forceinline__ void attn_sample_task(const Args& a, int task, int tid, int w, int lane, const f32x4 qpre) {
    unsigned char* ws = a.ws; const int b = task >> 2, h = task & 3;
    float* SC = (float*)smem;
    float* PS = (float*)(smem + 4096);
    float* RED = (float*)(smem + 8192);
    bf16_t* OX = (bf16_t*)(ws + WS_OX);
    float qv[4][8];
    {
        float* QL = RED;
        *(f32x4*)(QL + (tid >> 7) * 512 + (tid & 127) * 4) = qpre;
        __syncthreads();
#pragma unroll
        for (int j = 0; j < 4; ++j) { const f32x4 q0 = *(const f32x4*)(QL + j * 512 + 4 * lane), q1 = *(const f32x4*)(QL + j * 512 + 256 + 4 * lane);
#pragma unroll
            for (int d = 0; d < 4; ++d) { qv[j][d] = q0[d]; qv[j][4 + d] = q1[d]; } }
    }
    const float* Kb = a.in[3] + (((size_t)b * 256 + w) * 4 + h) * 512 + 4 * lane;
    const float* Vb = a.in[4] + (((size_t)b * 256 + w) * 4 + h) * 512 + 4 * lane;
    {
        f32x4 kb[2][8];
        const float* kp = Kb;
#pragma unroll
        for (int e = 0; e < 4; ++e) { const float* p = kp + (size_t)e * 16384; kb[0][2 * e] = __builtin_nontemporal_load((const f32x4*)p); kb[0][2 * e + 1] = __builtin_nontemporal_load((const f32x4*)(p + 256)); }
#pragma unroll 1
        for (int mp = 0; mp < 4; ++mp) {
#pragma unroll
            for (int hf = 0; hf < 2; ++hf) {
                if (hf == 0 || mp < 3) {
#pragma unroll
                    for (int e = 0; e < 4; ++e) { const float* p = kp + (size_t)(4 * (hf + 1) + e) * 16384; kb[hf ^ 1][2 * e] = __builtin_nontemporal_load((const f32x4*)p); kb[hf ^ 1][2 * e + 1] = __builtin_nontemporal_load((const f32x4*)(p + 256)); } }
                float pp[16];
#pragma unroll
                for (int e = 0; e < 4; ++e) { const f32x4 k0 = kb[hf][2 * e], k1 = kb[hf][2 * e + 1];
#pragma unroll
                    for (int j = 0; j < 4; ++j) pp[4 * e + j] = (qv[j][0] * k0[0] + qv[j][1] * k0[1]) + (qv[j][2] * k0[2] + qv[j][3] * k0[3]) + (qv[j][4] * k1[0] + qv[j][5] * k1[1]) + (qv[j][6] * k1[2] + qv[j][7] * k1[3]); }
                const float tot = reduce16(pp, lane);
                if ((lane & 3) == 0) { const int v = lane >> 2, e = v >> 2, j = v & 3; SC[j * 256 + 8 * (8 * mp + 4 * hf + e) + w] = tot; }
            }
            kp += 8 * 16384;
        }
    }
    f32x4 vb[2][8];
#pragma unroll
    for (int e = 0; e < 4; ++e) { const float* p = Vb + (size_t)e * 16384; vb[0][2 * e] = __builtin_nontemporal_load((const f32x4*)p); vb[0][2 * e + 1] = __builtin_nontemporal_load((const f32x4*)(p + 256)); }
    __syncthreads();
    if (w < 4) {
        float v[4]; float mx = -3.0e38f;
#pragma unroll
        for (int i = 0; i < 4; ++i) { v[i] = SC[w * 256 + lane + 64 * i]; mx = fmaxf(mx, v[i]); }
        mx = wave_max(mx); float sum = 0.f;
#pragma unroll
        for (int i = 0; i < 4; ++i) { v[i] = __expf(v[i] - mx); sum += v[i]; }
        sum = wave_sum(sum); const float inv = 1.0f / sum;
#pragma unroll
        for (int i = 0; i < 4; ++i) PS[(lane + 64 * i) * 4 + w] = v[i] * inv;
    }
    __syncthreads();
    float o[4][8];
#pragma unroll
    for (int j = 0; j < 4; ++j)
#pragma unroll
        for (int e = 0; e < 8; ++e) o[j][e] = 0.f;
    {
        const float* vp = Vb;
#pragma unroll 1
        for (int mp = 0; mp < 4; ++mp) {
#pragma unroll
            for (int hf = 0; hf < 2; ++hf) {
                if (hf == 0 || mp < 3) {
#pragma unroll
                    for (int e = 0; e < 4; ++e) { const float* p = vp + (size_t)(4 * (hf + 1) + e) * 16384; vb[hf ^ 1][2 * e] = __builtin_nontemporal_load((const f32x4*)p); vb[hf ^ 1][2 * e + 1] = __builtin_nontemporal_load((const f32x4*)(p + 256)); } }
#pragma unroll
                for (int e = 0; e < 4; ++e) { const f32x4 pr = *(const f32x4*)(PS + (8 * (8 * mp + 4 * hf + e) + w) * 4); const f32x4 v0 = vb[hf][2 * e], v1 = vb[hf][2 * e + 1];
#pragma unroll
                    for (int j = 0; j < 4; ++j) {
#pragma unroll
                        for (int d = 0; d < 4; ++d) { o[j][d] += pr[j] * v0[d]; o[j][4 + d] += pr[j] * v1[d]; } } }
            }
            vp += 8 * 16384;
        }
    }
#pragma unroll
    for (int j = 0; j < 4; ++j) { float* rp = RED + (w * 4 + j) * 512 + 4 * lane; *(f32x4*)rp = (f32x4){o[j][0], o[j][1], o[j][2], o[j][3]}; *(f32x4*)(rp + 256) = (f32x4){o[j][4], o[j][5], o[j][6], o[j][7]}; }
    __syncthreads();
#pragma unroll
    for (int i = 0; i < 4; ++i) { const int idx = tid + 512 * i, j = idx >> 9, d = idx & 511; float sm = 0.f;
#pragma unroll
        for (int ww = 0; ww < 8; ++ww) sm += RED[(ww * 4 + j) * 512 + d];
        OX[((size_t)NPR + 4 * b + j) * 2048 + h * 512 + d] = f2bf(sm); }
    __syncthreads();
}
__device__ __forceinline__ void conv_fixup_tile(const Args& a, int pm, int tid) {
    unsigned char* ws = a.ws; bf16_t* ACT = (bf16_t*)(ws + WS_ACT);
    const float* HAL = (const float*)(ws + WS_HAL); const float* HFA = (const float*)(ws + WS_HFA); const float* HFG = (const float*)(ws + WS_HFG);
    const float* cw = a.in[34]; const float* cb = a.in[35];
    for (int rem = tid; rem < 1408; rem += 512) {
        const int c = rem * 4;
        const f32x4 w0 = *(const f32x4*)(cw + c), w1 = *(const f32x4*)(cw + DFF + c), w2 = *(const f32x4*)(cw + 2 * DFF + c), bb = *(const f32x4*)(cb + c);
        const f32x4 am2 = *(const f32x4*)(HAL + ((size_t)(pm - 1) * 2) * DFF + c), am1 = *(const f32x4*)(HAL + ((size_t)(pm - 1) * 2 + 1) * DFF + c);
        const f32x4 a0 = *(const f32x4*)(HFA + ((size_t)pm * 2) * DFF + c), a1 = *(const f32x4*)(HFA + ((size_t)pm * 2 + 1) * DFF + c);
        const f32x4 g0 = *(const f32x4*)(HFG + ((size_t)pm * 2) * DFF + c), g1 = *(const f32x4*)(HFG + ((size_t)pm * 2 + 1) * DFF + c);
        const f32x4 o0 = gelu4(bb + am2 * w0 + am1 * w1 + a0 * w2) * g0, o1 = gelu4(bb + am1 * w0 + a0 * w1 + a1 * w2) * g1;
        u32x2 p0, p1; p0.x = cvt_pk_bf16(o0[0], o0[1]); p0.y = cvt_pk_bf16(o0[2], o0[3]); p1.x = cvt_pk_bf16(o1[0], o1[1]); p1.y = cvt_pk_bf16(o1[2], o1[3]);
        *(u32x2*)(ACT + (size_t)(pm * 256) * DFF + c) = p0; *(u32x2*)(ACT + (size_t)(pm * 256 + 1) * DFF + c) = p1;
    }
}
template <int MODE>
__device__ __forceinline__ void reduce_rows(const Args& a, int nsl, int bx, int G, int wave, int lane) {
    unsigned char* ws = a.ws; const float* SLAB = (const float*)(ws + WS_SLAB);
    for (int rs = bx * NWAVES + wave; rs < NSM; rs += G * NWAVES) {
        const size_t row = (size_t)NPR + rs; const int pmq = rs >> 8, rr = rs & 255;
        f32x4 v[8];
#pragma unroll
        for (int j = 0; j < 8; ++j) v[j] = (f32x4){0.f, 0.f, 0.f, 0.f};
        {
            const float* p0 = SLAB + (size_t)(pmq * 8 * nsl) * 65536 + (size_t)rr * 256 + 4 * lane; const size_t jstep = (size_t)nsl * 65536;
#pragma unroll 2
            for (int ks = 0; ks < nsl; ++ks) {
#pragma unroll
                for (int j = 0; j < 8; ++j) v[j] += __builtin_nontemporal_load((const f32x4*)(p0 + (size_t)j * jstep + (size_t)ks * 65536));
            }
        }
        const float sc = (MODE == 0) ? ((const float*)(ws + WS_RS5))[row] : 1.0f; float ss = 0.f;
        const bf16_t* bb = (const bf16_t*)(ws + (MODE == 2 ? WS_X2B : WS_X3B)) + row * DM;
#pragma unroll
        for (int j = 0; j < 8; ++j) {
            f32x4 bv;
            if (MODE == 0) bv = ((const f32x4*)(a.in[1] + (size_t)rs * DM))[lane + 64 * j];
            else { const u32x2 w = ((const u32x2*)bb)[lane + 64 * j]; bv = (f32x4){bflo(w.x), bfhi(w.x), bflo(w.y), bfhi(w.y)}; }
            v[j] = bv + v[j] * sc; ss += (v[j][0] * v[j][0] + v[j][1] * v[j][1]) + (v[j][2] * v[j][2] + v[j][3] * v[j][3]);
        }
        ss = wave_sum(ss);
        if (MODE == 3) {
            const float r = rsqrtf(ss * (1.0f / 2048.0f) + EPS); const float* nf = a.in[37]; f32x4* y = (f32x4*)(a.out + O_Y + row * DM);
#pragma unroll
            for (int j = 0; j < 8; ++j) { const f32x4 g = ((const f32x4*)nf)[lane + 64 * j]; y[lane + 64 * j] = (v[j] * r) * g; }
        } else {
            bf16_t* XBo = (bf16_t*)(ws + (MODE == 0 ? WS_X2B : WS_X3B)) + row * DM; float* SS = (float*)(ws + (MODE == 0 ? WS_SS2 : WS_SS3));
#pragma unroll
            for (int j = 0; j < 8; ++j) { u32x2 w; w.x = cvt_pk_bf16(v[j][0], v[j][1]); w.y = cvt_pk_bf16(v[j][2], v[j][3]); ((u32x2*)XBo)[lane + 64 * j] = w; }
            if (lane < 32) SS[row * 32 + lane] = (lane == 0) ? ss : 0.f;
            if (lane == 0) ((float*)(ws + (MODE == 0 ? WS_R2 : WS_R3)))[row] = rsqrtf(ss * (1.0f / 2048.0f) + EPS);
        }
    }
}
__device__ __forceinline__ void final_norm(const Args& a, int bx, int G, int wave, int lane) {
    const float* SS4 = (const float*)(a.ws + WS_SS4); const float* nf = a.in[37]; const bf16_t* X4 = (const bf16_t*)(a.ws + WS_X2);
    for (int row = bx * NWAVES + wave; row < NPR; row += G * NWAVES) {
        const float ss = wave_sum(lane < 32 ? SS4[(size_t)row * 32 + lane] : 0.f); const float r = rsqrtf(ss * (1.0f / 2048.0f) + EPS);
        f32x4* y = (f32x4*)(a.out + O_Y + (size_t)row * DM); const u32x2* xb = (const u32x2*)(X4 + (size_t)row * DM);
#pragma unroll
        for (int j = 0; j < 8; ++j) { const f32x4 g = ((const f32x4*)nf)[lane + 64 * j]; const u32x2 w = __builtin_nontemporal_load(xb + lane + 64 * j);
            f32x4 v = (f32x4){bflo(w.x), bfhi(w.x), bflo(w.y), bfhi(w.y)}; v = v * r; v = v * g; __builtin_nontemporal_store(v, y + lane + 64 * j); }
    }
}

__device__ __forceinline__ void row_rsqrt_pass(const float* SS, float* RR, int bx, int G, int wave, int lane) {
    for (int row = bx * NWAVES + wave; row < NPR; row += G * NWAVES) {
        const float tot = wave_sum(lane < 32 ? SS[(size_t)row * 32 + lane] : 0.f);
        if (lane == 0) RR[row] = rsqrtf(tot * (1.0f / 2048.0f) + EPS);
    }
}
__global__ void __launch_bounds__(NWAVES * 64, 2) hymba_fwd(Args args) {
    int tid = threadIdx.x, lane = tid & 63, wave = __builtin_amdgcn_readfirstlane(tid >> 6);
    const int G = gridDim.x, bx = blockIdx.x;
    const int vcu = (G % 8 == 0) ? (bx % 8) * (G / 8) + bx / 8 : bx;
    unsigned char* ws = args.ws;
    unsigned* ctl = (unsigned*)(ws + WS_CTL);
    volatile LAS unsigned* MISC = (volatile LAS unsigned*)((LAS unsigned char*)smem + MISC_OFF);
    if (tid < 32) MISC[tid] = 0u;
    __syncthreads();
    XcdBarrier bar; bar.bar = ctl + CW_BAR + args.li * XCD_BAR_WORDS; bar.x = 0; bar.st = nullptr;
    if (MK_N_LAUNCHES == 1) bar = xcd_barrier_post(ctl + CW_BAR + args.li * XCD_BAR_WORDS, MISC + 8);
    const int lo = args.ph_lo, hi = args.ph_hi;
#ifndef PH_MASK
#define PH_MASK 0x3FFF
#endif
#define IN(k) (((PH_MASK >> (k)) & 1) && lo <= (k) && (k) < hi)
#ifndef TIMED_PHASE
#define TIMED_PHASE -1
#endif
#ifndef TIME_MULT
#define TIME_MULT 2
#endif
    if (TIMED_PHASE >= 0 && bx == 0 && tid == 0) { const unsigned long long t0_ = __builtin_amdgcn_s_memrealtime(); MISC[16] = (unsigned)t0_; MISC[17] = (unsigned)(t0_ >> 32); }
#define STAMP(k) do { if (TIMED_PHASE >= 0 && bx == 0) { if (threadIdx.x == 0) { const unsigned long long t_now = __builtin_amdgcn_s_memrealtime(); \
        if (TIMED_PHASE == (k)) { const unsigned long long t_pr = ((unsigned long long)MISC[17] << 32) | MISC[16]; const unsigned long long dl = (t_now - t_pr) * TIME_MULT; while (__builtin_amdgcn_s_memrealtime() - t_now < dl) __builtin_amdgcn_s_sleep(8); } \
        const unsigned long long t2_ = __builtin_amdgcn_s_memrealtime(); MISC[16] = (unsigned)t2_; MISC[17] = (unsigned)(t2_ >> 32); } __syncthreads(); } } while (0)
#define SEAM(k) do { if (IN(k) && IN((k) + 1)) xcd_barrier(bar); STAMP(k); asm volatile("" : "+v"(tid)); lane = tid & 63; wave = __builtin_amdgcn_readfirstlane(tid >> 6); } while (0)
    LAS unsigned char* lds = (LAS unsigned char*)smem;
    const size_t TS2048 = (size_t)256 * 2048 * 2, TS5632 = (size_t)256 * 5632 * 2;

    if (IN(0)) { p0_prologue(args, bx, G, tid, wave, lane); }
    SEAM(0);
    if (IN(1)) {
        pg8::SchedJ<3> S; S.G = G; S.c = bx; S.nt = 32; S.tstep = TS2048;
        S.jb[0] = pg8::JobDesc{(const char*)(ws + WS_XB), (const char*)(ws + WS_WIN), 34, 17};
        S.jb[1] = pg8::JobDesc{(const char*)(ws + WS_MEMB), (const char*)(ws + WS_WXKV), 4, 16};
        S.jb[2] = pg8::JobDesc{(const char*)(ws + WS_WXKV) + (size_t)2048 * 2048 * 2, (const char*)(ws + WS_MEMB), 8, 4};
        EpiP1 E{(const float*)(ws + WS_R1), (const float*)(ws + WS_RMEM), (bf16_t*)(ws + WS_U), (bf16_t*)(ws + WS_PROJ), (float*)(ws + WS_GLOW), args.out, (bf16_t*)(ws + WS_MKB), (bf16_t*)(ws + WS_MVT)};
        pg8::gemm_phase(lds, 2048, S, E, tid);
        {
            const int first = (G == 256) ? 162 : 0;
            if (bx >= first) { float* scr = (float*)smem + wave * 4160; const int nw = (G - first) * NWAVES;
                for (int it = TR_NITEMS - TR_DEFER + (bx - first) * NWAVES + wave; it < TR_NITEMS; it += nw) transpose_dispatch(args, it, scr, lane); }
        }
    }
    SEAM(1);
    if (IN(2)) {
        for (int t = bx; t < 256; t += G) s5_prompt_task(args, t >> 6, t & 63, tid, wave, lane);
        if (G == 256) {
            if (bx >= 192) { gla_a_task(args, 448 + (bx - 192), tid, wave, lane); s5_sample_task(args, bx - 192, tid, wave, lane); }
            else { for (int t = bx; t < 448; t += 192) gla_a_task(args, t, tid, wave, lane); }
        } else {
            for (int t = bx; t < 512; t += G) gla_a_task(args, t, tid, wave, lane);
            for (int t = G - 1 - bx; t < 64; t += G) s5_sample_task(args, t, tid, wave, lane);
        }
    }
    SEAM(2);
    if (IN(3)) {
        gla_b_scan(args, bx, G, tid);
        for (int t = bx; t < 512; t += G) gla_sample_task(args, t, tid, wave, lane);
    }
    SEAM(3);
    if (IN(4)) { for (int t = bx; t < 512; t += G) gla_c_task(args, t, tid, wave, lane); }
    SEAM(4);
    float* SLAB = (float*)(ws + WS_SLAB);
    if (IN(5)) {
        pg8::SchedMS S{(const char*)(ws + WS_YCAT), (const char*)(ws + WS_WOUT), G, bx, 32, 8, 4, TS2048};
        EpiRes<false> E{args.in[0], args.in[1], nullptr, (bf16_t*)(ws + WS_X2B), (float*)(ws + WS_SS2), (const float*)(ws + WS_RS5), SLAB, 8};
        pg8::gemm_phase(lds, 2048, S, E, tid);
    }
    SEAM(5);
    if (IN(6)) { reduce_rows<0>(args, 8, bx, G, wave, lane); row_rsqrt_pass((const float*)(ws + WS_SS2), (float*)(ws + WS_R2), bx, G, wave, lane); }
    SEAM(6);
    if (IN(7)) {
        pg8::SchedMS S{(const char*)(ws + WS_X2B), (const char*)(ws + WS_WXQ), G, bx, 32, 8, 4, TS2048};
        EpiScale E{(const float*)(ws + WS_R2), (bf16_t*)(ws + WS_QX), 0.04419417382415922f, SLAB, 8};
        pg8::gemm_phase(lds, 2048, S, E, tid);
    }
    SEAM(7);
    if (IN(8)) {
        if (G == 256) {
            f32x4* QP = (f32x4*)(smem + QPRE_OFF);
            { const f32x4 q0 = attn_q_combine(args, bx, tid), q1 = attn_q_combine(args, bx + 256, tid); QP[tid] = q0; QP[512 + tid] = q1; }
            attn_prompt_task(args, vcu, tid, wave, lane);
            attn_sample_task(args, bx, tid, wave, lane, QP[tid]);
            attn_sample_task(args, bx + 256, tid, wave, lane, QP[512 + tid]);
        } else {
            for (int t = vcu; t < 256; t += G) attn_prompt_task(args, t, tid, wave, lane);
            for (int t = bx; t < 512; t += G) attn_sample_task(args, t, tid, wave, lane, attn_q_combine(args, t, tid));
        }
    }
    SEAM(8);
    if (IN(9)) {
        pg8::SchedMS S{(const char*)(ws + WS_OX), (const char*)(ws + WS_WXO), G, bx, 32, 8, 4, TS2048};
        EpiRes<true> E{(const void*)(ws + WS_X2B), nullptr, nullptr, (bf16_t*)(ws + WS_X3B), (float*)(ws + WS_SS3), nullptr, SLAB, 8};
        pg8::gemm_phase(lds, 2048, S, E, tid);
    }
    SEAM(9);
    if (IN(10)) { reduce_rows<2>(args, 8, bx, G, wave, lane); row_rsqrt_pass((const float*)(ws + WS_SS3), (float*)(ws + WS_R3), bx, G, wave, lane); }
    SEAM(10);
    if (IN(11)) {
        pg8::SchedJ<2> S; S.G = G; S.c = bx; S.nt = 32; S.tstep = TS2048;
        S.jb[0] = pg8::JobDesc{(const char*)(ws + WS_X3B), (const char*)(ws + WS_WUP), 32, 44, 0};
        S.jb[1] = pg8::JobDesc{(const char*)(ws + WS_X3B) + (size_t)32 * TS2048, (const char*)(ws + WS_WUP), 2, 44, 32};
        EpiUp E{(const float*)(ws + WS_R3), (bf16_t*)(ws + WS_ACT), args.out, args.in[34], args.in[35], args.in[8], (float*)(ws + WS_HAL), (float*)(ws + WS_HFA), (float*)(ws + WS_HFG)};
        pg8::gemm_phase(lds, 2048, S, E, tid);
    }
    SEAM(11);
    if (IN(12)) {
        pg8::SchedMS S{(const char*)(ws + WS_ACT), (const char*)(ws + WS_WDN), G, bx, 88, 11, 8, TS5632};
        {
            pg8::Unit u;
            for (int i = 0; S.next(i, u); ++i) if (u.job == 0 && (u.pm & 7) != 0) conv_fixup_tile(args, u.pm, tid);
            asm volatile("s_waitcnt vmcnt(0)" ::: "memory"); __syncthreads();
        }
        EpiRes<true> E{(const void*)(ws + WS_X3B), nullptr, nullptr, (bf16_t*)(ws + WS_X2), (float*)(ws + WS_SS4), nullptr, SLAB, 11};
        pg8::gemm_phase(lds, 5632, S, E, tid);
    }
    SEAM(12);
    if (IN(13)) { final_norm(args, bx, G, wave, lane); reduce_rows<3>(args, 11, bx, G, wave, lane); }
    if (TIMED_PHASE == 13) { asm volatile("s_waitcnt vmcnt(0)" ::: "memory"); __syncthreads(); STAMP(13); }
#undef IN
#undef SEAM
}

extern "C" void kernel_launch(void* const* d_in, const int* in_sizes, int n_in, void* d_out, int out_size, void* d_ws, size_t ws_size, hipStream_t stream) {
    static int grid = 0;
    if (grid == 0) {
        if (n_in != 38 || (size_t)out_size != O_END || ws_size < WS_END2) { fprintf(stderr, "kernel_launch: unexpected shapes: n_in %d out %d ws %zu\n", n_in, out_size, ws_size); grid = -1; return; }
        int dev = 0, cus = 0, per_cu = 0;
        if (hipGetDevice(&dev) != hipSuccess || hipDeviceGetAttribute(&cus, hipDeviceAttributeMultiprocessorCount, dev) != hipSuccess) { grid = -1; return; }
        if (hipFuncSetAttribute((const void*)hymba_fwd, hipFuncAttributeMaxDynamicSharedMemorySize, LDS_BYTES) != hipSuccess) { fprintf(stderr, "kernel_launch: hipFuncSetAttribute failed\n"); grid = -1; return; }
        if (hipOccupancyMaxActiveBlocksPerMultiprocessor(&per_cu, (const void*)hymba_fwd, NWAVES * 64, LDS_BYTES) != hipSuccess || per_cu < 1) { fprintf(stderr, "kernel_launch: occupancy query reports %d\n", per_cu); }
        (void)hipGetLastError();
        grid = cus;
    }
    if (grid < 0) return;
    (void)hipMemsetAsync((char*)d_ws + WS_CTL, 0, CTL_ZERO_BYTES, stream);
    Args a{};
    for (int i = 0; i < 38; ++i) a.in[i] = (const float*)d_in[i];
    a.out = (float*)d_out; a.ws = (unsigned char*)d_ws;
#if MK_N_LAUNCHES == 1
    a.ph_lo = 0; a.ph_hi = MK_PH_END; a.li = 0;
    hipLaunchKernelGGL(hymba_fwd, dim3(grid), dim3(NWAVES * 64), LDS_BYTES, stream, a);
#else
    for (int ph = 0; ph < MK_PH_END; ++ph) { a.ph_lo = ph; a.ph_hi = ph + 1; a.li = 0; hipLaunchKernelGGL(hymba_fwd, dim3(grid), dim3(NWAVES * 64), LDS_BYTES, stream, a); }
#endif
}
```

```cpp
#include <hip/hip_runtime.h>
#include <cstdio>
#include <cstdint>

#define LAS __attribute__((address_space(3)))
typedef unsigned short bf16_t;
typedef short bf16x8 __attribute__((ext_vector_type(8)));
typedef float f32x4 __attribute__((ext_vector_type(4)));
typedef float f32x2 __attribute__((ext_vector_type(2)));
typedef unsigned u32x4 __attribute__((ext_vector_type(4)));
typedef unsigned u32x2 __attribute__((ext_vector_type(2)));

#ifndef MK_N_LAUNCHES
#define MK_N_LAUNCHES 1
#endif
#ifndef MK_PH_END
#define MK_PH_END 14
#endif

constexpr int DM = 2048, NPR = 8192, NSM = 512, MT = 8704;
constexpr int DFF = 5632, NIN = 4352, NMEMR = 1024;
constexpr float EPS = 1e-6f;
constexpr size_t O_Y = 0, O_MK = 17825792, O_MV = 19922944, O_S5RE_P = 22020096, O_S5IM_P = 22036480, O_GLA_P = 22052864,
                 O_CONV_P = 22577152, O_S5RE_S = 22622208, O_S5IM_S = 23146496, O_GLA_S = 23670784, O_CONV_S = 40448000, O_END = 41889792;
constexpr size_t MiB = 1u << 20;
constexpr size_t WS_CTL = 0, CTL_ZERO_BYTES = 1 * MiB;
constexpr size_t WS_R1 = 1 * MiB, WS_RMEM = 1 * MiB + 65536, WS_R2 = 1 * MiB + 131072, WS_R3 = 1 * MiB + 196608;
constexpr size_t WS_SS2 = 2 * MiB, WS_SS3 = 4 * MiB, WS_SS4 = 6 * MiB, WS_S5SS = 8 * MiB, WS_GSS = 11 * MiB, WS_GLOW = 12 * MiB;
constexpr size_t WS_KT = 13 * MiB, WS_A16 = 14 * MiB, WS_A4 = 14 * MiB + 65536, WS_M2T = 15 * MiB, WS_M3T = 19 * MiB;
constexpr size_t WS_WIN = 24 * MiB, WS_WOUT = 42 * MiB, WS_WXQ = 50 * MiB, WS_WXKV = 58 * MiB, WS_WXO = 74 * MiB, WS_WUP = 82 * MiB, WS_WDN = 126 * MiB;
constexpr size_t WS_XB = 148 * MiB, WS_MEMB = 182 * MiB, WS_U = 186 * MiB, WS_PROJ = 203 * MiB, WS_MKB = 254 * MiB, WS_MVT = 258 * MiB;
constexpr size_t WS_YCAT = 262 * MiB, WS_OG = 296 * MiB, WS_X2 = 313 * MiB, WS_X2B = 381 * MiB, WS_QX = 415 * MiB, WS_OX = 449 * MiB;
constexpr size_t WS_X3 = 483 * MiB, WS_X3B = 551 * MiB, WS_AB = 585 * MiB, WS_GB = 679 * MiB, WS_ACT = 773 * MiB, WS_END = 867 * MiB;
constexpr size_t WS_KVC = WS_AB, WS_SPREV = WS_GB, WS_QTG = WS_ACT, WS_DECG = WS_ACT + 16 * MiB, WS_RS5 = WS_GSS;
constexpr size_t WS_HAL = WS_X3, WS_HFA = WS_X3 + 2 * MiB, WS_HFG = WS_X3 + 4 * MiB;
constexpr size_t WS_SLAB = 867 * MiB, WS_END2 = 931 * MiB;
constexpr int CW_BAR = 4096;

constexpr int NWAVES = 8;
constexpr int LDS_BYTES = 163840;
constexpr int QPRE_OFF = 147456;
constexpr int MISC_OFF = 144384;

typedef __bf16 bf16x2_t __attribute__((ext_vector_type(2)));
__device__ __forceinline__ unsigned cvt_pk_bf16(float lo, float hi) { const f32x2 v = {lo, hi}; const bf16x2_t b = __builtin_convertvector(v, bf16x2_t); return __builtin_bit_cast(unsigned, b); }
__device__ __forceinline__ bf16_t f2bf(float f) { return (bf16_t)(cvt_pk_bf16(f, 0.f) & 0xffffu); }
__device__ __forceinline__ float bf2f(bf16_t v) { return __uint_as_float(((unsigned)v) << 16); }
__device__ __forceinline__ float bflo(unsigned w) { return __uint_as_float(w << 16); }
__device__ __forceinline__ float bfhi(unsigned w) { return __uint_as_float(w & 0xffff0000u); }
__device__ __forceinline__ float gelu1(float v) {
    const float av = fabsf(v), d = av * 0.2316418882f + 1.0f; const float t = __builtin_amdgcn_rcpf(d);
    float q = t * 0.5307027145f + (-0.7265760135f); q = q * t + 0.7107068705f; q = q * t + (-0.142248368f); q = q * t + 0.127414796f; q = q * t;
    const float e = __builtin_amdgcn_exp2f((v * v) * (-0.72134752044f));
    const float m = v * (q * e); return v < 0.f ? m : v - m;
}
__device__ __forceinline__ float sigmoid1(float x) { return 1.0f / (1.0f + __expf(-x)); }
__device__ __forceinline__ float logsigmoid1(float z) { return fminf(z, 0.f) - log1pf(expf(-fabsf(z))); }
__device__ __forceinline__ float wave_sum(float v) {
#pragma unroll
    for (int o = 1; o < 64; o <<= 1) v += __shfl_xor(v, o);
    return v;
}
__device__ __forceinline__ float wave_max(float v) {
#pragma unroll
    for (int o = 1; o < 64; o <<= 1) v = fmaxf(v, __shfl_xor(v, o));
    return v;
}
__device__ __forceinline__ f32x4 mma16(bf16x8 bfrag, bf16x8 afrag, f32x4 acc) { return __builtin_amdgcn_mfma_f32_16x16x32_bf16(bfrag, afrag, acc, 0, 0, 0); }
__device__ __forceinline__ bf16x8 ldg8(const bf16_t* p) { return *(const bf16x8*)p; }
__device__ __forceinline__ bf16x8 pack8(const f32x4 a, const f32x4 b) {
    u32x4 w; w.x = cvt_pk_bf16(a[0], a[1]); w.y = cvt_pk_bf16(a[2], a[3]); w.z = cvt_pk_bf16(b[0], b[1]); w.w = cvt_pk_bf16(b[2], b[3]);
    return __builtin_bit_cast(bf16x8, w);
}

struct Args { const float* in[38]; float* out; unsigned char* ws; int ph_lo, ph_hi, li, pad; };

namespace pg8 {
constexpr int BM = 256, BK = 64, HALF = 128, HTB = HALF * BK * 2, STAGE_BYTES = 8 * HTB, NXCD = 8, WGM = 8;
__device__ __forceinline__ int lds_byte(int r, int c) { const int st = (r >> 4) * 2 + (c >> 5), rr = r & 15, cc = c & 31, ob = rr * 64 + cc * 2; return st * 1024 + (ob ^ (((ob >> 9) & 1) << 5)); }
__device__ __forceinline__ void stage_rc(int b, int& R, int& C) { const int st = b / 1024, sb = b % 1024, swz = sb ^ (((sb >> 9) & 1) << 5); R = (st >> 1) * 16 + swz / 64; C = (st & 1) * 32 + (swz % 64) / 2; }
__device__ __forceinline__ int perm32(int rho) { const int n = rho >> 4, i = rho & 15; return 8 * (i >> 2) + 4 * n + (i & 3); }

struct Unit { const char* pa; const char* pb; int pm, pn, job, nt, ks; };
struct JobDesc { const char* A; const char* B; int nM, nN, pm0; };
template <int NJ> struct SchedJ {
    JobDesc jb[NJ]; int G, c, nt; size_t tstep;
    __device__ __forceinline__ bool next(int i, Unit& u) const {
        long L = (long)i * G + c;
#pragma unroll
        for (int j = 0; j < NJ; ++j) {
            const int nM = jb[j].nM, nN = jb[j].nN, nwg = nM * nN;
            if (L < nwg) {
                int wgid = (int)L; { const int q = nwg / NXCD, r = nwg % NXCD, xcd = wgid % NXCD, off = wgid / NXCD; wgid = (xcd < r ? xcd * (q + 1) : r * (q + 1) + (xcd - r) * q) + off; }
                const int nig = WGM * nN, gid = wgid / nig, fm = gid * WGM, gsz = (nM - fm) < WGM ? (nM - fm) : WGM;
                const int pml = fm + ((wgid % nig) % gsz); u.pm = jb[j].pm0 + pml; u.pn = (wgid % nig) / gsz; u.job = j; u.nt = nt; u.ks = 0;
                u.pa = jb[j].A + (size_t)pml * tstep; u.pb = jb[j].B + (size_t)u.pn * tstep; return true;
            }
            L -= nwg;
        }
        return false;
    }
};

struct SchedMS {
    const char* A; const char* B; int G, c, nt, nsl, ntsl; size_t tstep;
    __device__ __forceinline__ bool next(int i, Unit& u) const {
        const long L = (long)i * G + c;
        if (L < 256) {
            int wgid = (int)L; { const int xcd = wgid % NXCD, off = wgid / NXCD; wgid = xcd * 32 + off; }
            const int nig = WGM * 8, gid = wgid / nig, fm = gid * WGM;
            u.pm = fm + ((wgid % nig) % WGM); u.pn = (wgid % nig) / WGM; u.job = 0; u.nt = nt; u.ks = 0;
            u.pa = A + (size_t)u.pm * tstep; u.pb = B + (size_t)u.pn * tstep; return true;
        }
        const long s_ = L - 256;
        if (s_ < 16 * nsl) {
            const int ts = (int)s_ / nsl, ks = (int)s_ - ts * nsl;
            u.pm = 32 + (ts >> 3); u.pn = ts & 7; u.job = 1; u.nt = ntsl; u.ks = ks;
            u.pa = A + (size_t)u.pm * tstep + (size_t)ks * ntsl * 128; u.pb = B + (size_t)u.pn * tstep + (size_t)ks * ntsl * 128; return true;
        }
        return false;
    }
};

template <class Epi, class Sched>
__device__ __forceinline__ void gemm_phase(LAS unsigned char* lds, const int K, const Sched& S, const Epi& E, const int tid) {
    const int wid = __builtin_amdgcn_readfirstlane(tid >> 6), lane = tid & 63, wr = wid >> 2, wc = wid & 3, fr = lane & 15, fq = lane >> 4;
    unsigned voffA[2], voffB[2];
#pragma unroll
    for (int i = 0; i < 2; ++i) { int R, C; stage_rc(tid * 16 + i * 8192, R, C); const int Rb = (R & ~31) + perm32(R & 31);
        voffA[i] = (unsigned)(R * K + C) * 2u; voffB[i] = (unsigned)(Rb * K + C) * 2u; }
    const size_t kstep = (size_t)(BK * 2);
    const size_t hstep = (size_t)HALF * K * 2;
    const unsigned ldsw = (unsigned)wid * 1024u;
    const int aoff = lds_byte(wr * 64 + fr, fq * 8), boff = lds_byte(wc * 32 + fr, fq * 8);
#define PG8_SA(b, h) (((b) * 2 + (h)) * HTB)
#define PG8_SB(b, h) ((4 + (b) * 2 + (h)) * HTB)
#define PG8_STAGE(bufoff, gbase, voff) do { _Pragma("unroll") for (int _i = 0; _i < 2; ++_i) \
        __builtin_amdgcn_global_load_lds((const unsigned*)((const char*)(gbase) + (voff)[_i]), (LAS unsigned*)(lds + (bufoff) + ldsw + _i * 8192), 16, 0, 0); } while (0)
#define PG8_LDA(dst, b, h) do { _Pragma("unroll") for (int m = 0; m < 4; ++m) _Pragma("unroll") for (int k = 0; k < 2; ++k) dst[m][k] = *(const LAS bf16x8*)(lds + PG8_SA(b, h) + aoff + m * 2048 + k * 1024); } while (0)
#define PG8_LDB(dst, b, h) do { _Pragma("unroll") for (int n = 0; n < 2; ++n) _Pragma("unroll") for (int k = 0; k < 2; ++k) dst[n][k] = *(const LAS bf16x8*)(lds + PG8_SB(b, h) + boff + n * 2048 + k * 1024); } while (0)
#define PG8_MMA(ai, bj, At, Bt) do { __builtin_amdgcn_s_setprio(1); _Pragma("unroll") for (int m = 0; m < 4; ++m) _Pragma("unroll") for (int n = 0; n < 2; ++n) _Pragma("unroll") for (int k = 0; k < 2; ++k) \
        acc[ai][bj][m][n] = __builtin_amdgcn_mfma_f32_16x16x32_bf16(Bt[n][k], At[m][k], acc[ai][bj][m][n], 0, 0, 0); __builtin_amdgcn_s_setprio(0); } while (0)
#define PG8_WAIT_V(n) asm volatile("s_waitcnt vmcnt(" #n ")" ::: "memory")
#define PG8_WAIT_L(n) asm volatile("s_waitcnt lgkmcnt(" #n ")" ::: "memory")
#define PG8_BAR __builtin_amdgcn_s_barrier()
#define PG8_SCHED __builtin_amdgcn_sched_barrier(0)
    Unit cur, nxt; int ui = 0;
    if (!S.next(0, cur)) return;
    f32x4 acc[2][2][4][2];
#pragma unroll
    for (int a = 0; a < 2; ++a)
#pragma unroll
        for (int b = 0; b < 2; ++b)
#pragma unroll
            for (int m = 0; m < 4; ++m)
#pragma unroll
                for (int n = 0; n < 2; ++n) acc[a][b][m][n] = (f32x4){0.f, 0.f, 0.f, 0.f};
    bf16x8 At[4][2], B0[2][2], B1[2][2];
    float pre[2][4];
    const char* cA = cur.pa; const char* cB = cur.pb;
    PG8_STAGE(PG8_SB(0, 0), cB, voffB); PG8_STAGE(PG8_SB(0, 1), cB + hstep, voffB); PG8_STAGE(PG8_SA(0, 0), cA, voffA); PG8_STAGE(PG8_SA(0, 1), cA + hstep, voffA);
    if (wr == 1) PG8_BAR;
    PG8_WAIT_V(2); PG8_BAR;
    PG8_STAGE(PG8_SB(1, 0), cB + kstep, voffB); PG8_STAGE(PG8_SA(1, 0), cA + kstep, voffA); PG8_STAGE(PG8_SB(1, 1), cB + hstep + kstep, voffB);
    PG8_WAIT_V(6); PG8_BAR;
    for (;;) {
        const bool has_next = S.next(ui + 1, nxt);
        const char* nA = has_next ? nxt.pa : cA; const char* nB = has_next ? nxt.pb : cB;
        const int nt = cur.nt;
        for (int t = 0; t < nt; t += 2) {
            const bool last = (t == nt - 2);
            const char* a1 = cA + (size_t)(t + 1) * kstep;
            const char* a2 = last ? nA : cA + (size_t)(t + 2) * kstep; const char* b2 = last ? nB : cB + (size_t)(t + 2) * kstep;
            const char* a3 = a2 + kstep; const char* b3 = b2 + kstep;
            if (last) E.prefetch(cur, wr, fr, pre);
            PG8_LDB(B0, 0, 0); PG8_LDB(B1, 0, 1); PG8_SCHED; PG8_LDA(At, 0, 0); PG8_STAGE(PG8_SA(1, 1), a1 + hstep, voffA);
            PG8_WAIT_V(8); PG8_WAIT_L(0); PG8_BAR; PG8_MMA(0, 0, At, B0); PG8_MMA(0, 1, At, B1); PG8_BAR; PG8_SCHED;
            PG8_LDA(At, 0, 1); PG8_STAGE(PG8_SB(0, 0), b2, voffB); PG8_STAGE(PG8_SB(0, 1), b2 + hstep, voffB); PG8_STAGE(PG8_SA(0, 0), a2, voffA);
            PG8_WAIT_V(8); PG8_WAIT_L(0); PG8_BAR; PG8_MMA(1, 0, At, B0); PG8_MMA(1, 1, At, B1); PG8_BAR; PG8_SCHED;
            PG8_LDB(B0, 1, 0); PG8_LDB(B1, 1, 1); PG8_SCHED; PG8_LDA(At, 1, 0); PG8_STAGE(PG8_SA(0, 1), a2 + hstep, voffA);
            PG8_WAIT_V(8); PG8_WAIT_L(0); PG8_BAR; PG8_MMA(0, 0, At, B0); PG8_MMA(0, 1, At, B1); PG8_BAR; PG8_SCHED;
            PG8_LDA(At, 1, 1); PG8_STAGE(PG8_SB(1, 0), b3, voffB); PG8_STAGE(PG8_SB(1, 1), b3 + hstep, voffB); PG8_STAGE(PG8_SA(1, 0), a3, voffA);
            PG8_WAIT_V(8); PG8_WAIT_L(0); PG8_BAR; PG8_MMA(1, 0, At, B0); PG8_MMA(1, 1, At, B1); PG8_BAR; PG8_SCHED;
        }
        if (wr == 0) PG8_BAR;
        E(acc, cur, wr, wc, fr, fq, pre);
        if (!has_next) break;
#pragma unroll
        for (int a = 0; a < 2; ++a)
#pragma unroll
            for (int b = 0; b < 2; ++b)
#pragma unroll
                for (int m = 0; m < 4; ++m)
#pragma unroll
                    for (int n = 0; n < 2; ++n) acc[a][b][m][n] = (f32x4){0.f, 0.f, 0.f, 0.f};
        cur = nxt; cA = nA; cB = nB; ++ui;
        if (wr == 1) PG8_BAR;
    }
    PG8_WAIT_V(0);
    PG8_BAR;
#undef PG8_SA
#undef PG8_SB
#undef PG8_STAGE
#undef PG8_LDA
#undef PG8_LDB
#undef PG8_MMA
#undef PG8_WAIT_V
#undef PG8_WAIT_L
#undef PG8_BAR
#undef PG8_SCHED
}
}

typedef f32x4 AccT[2][2][4][2];
extern __shared__ __attribute__((aligned(16))) unsigned char smem[];

__device__ __forceinline__ void row_rs8(const float* SS, int rowbase  , int fq, float (&rs)[2][4]) {
#pragma unroll
    for (int ai = 0; ai < 2; ++ai)
#pragma unroll
        for (int m = 0; m < 4; ++m) {
            const int r = rowbase + ai * 128 + m * 16;
            const f32x4 a = *(const f32x4*)(SS + (size_t)r * 32 + fq * 8), b = *(const f32x4*)(SS + (size_t)r * 32 + fq * 8 + 4);
            float s = (a[0] + a[1]) + (a[2] + a[3]) + (b[0] + b[1]) + (b[2] + b[3]);
            s += __shfl_xor(s, 16); s += __shfl_xor(s, 32);
            rs[ai][m] = rsqrtf(s * (1.0f / 2048.0f) + EPS);
        }
}
__device__ __forceinline__ void st_bf16x8_nt(bf16_t* p, const f32x4 v0, const f32x4 v1) {
    u32x4 w; w.x = cvt_pk_bf16(v0[0], v0[1]); w.y = cvt_pk_bf16(v0[2], v0[3]); w.z = cvt_pk_bf16(v1[0], v1[1]); w.w = cvt_pk_bf16(v1[2], v1[3]);
    __builtin_nontemporal_store(w, (u32x4*)p);
}
__device__ __forceinline__ void st_bf16x8(bf16_t* p, const f32x4 v0, const f32x4 v1) {
    u32x4 w; w.x = cvt_pk_bf16(v0[0], v0[1]); w.y = cvt_pk_bf16(v0[2], v0[3]); w.z = cvt_pk_bf16(v1[0], v1[1]); w.w = cvt_pk_bf16(v1[2], v1[3]);
    *(u32x4*)p = w;
}

__device__ __forceinline__ void slab_store(const AccT& acc, const pg8::Unit& u, float* SLAB, int nsl, int wr, int wc, int fr, int fq) {
    const int ts = (u.pm - 32) * 8 + u.pn; float* base = SLAB + (size_t)(ts * nsl + u.ks) * 65536;
#pragma unroll
    for (int ai = 0; ai < 2; ++ai)
#pragma unroll
        for (int m = 0; m < 4; ++m) { const int r = ai * 128 + wr * 64 + m * 16 + fr;
#pragma unroll
            for (int bj = 0; bj < 2; ++bj) { float* p = base + (size_t)r * 256 + bj * 128 + wc * 32 + fq * 8; *(f32x4*)p = acc[ai][bj][m][0]; *(f32x4*)(p + 4) = acc[ai][bj][m][1]; } }
}

struct EpiP1 {
    const float* r1; const float* rmem; bf16_t* U; bf16_t* PROJ; float* GLOW; float* out; bf16_t* MKB; bf16_t* MVT;
    __device__ __forceinline__ void prefetch(const pg8::Unit& u, int wr, int fr, float (&pre)[2][4]) const {
        const float* rp = (u.job == 0 ? r1 : rmem) + u.pm * 256 + wr * 64 + fr;
#pragma unroll
        for (int ai = 0; ai < 2; ++ai)
#pragma unroll
            for (int m = 0; m < 4; ++m) pre[ai][m] = (u.job == 2) ? 1.0f : rp[ai * 128 + m * 16];
    }
    __device__ __forceinline__ void operator()(const AccT& acc, const pg8::Unit& u, int wr, int wc, int fr, int fq, const float (&pre)[2][4]) const {
        const int rb = u.pm * 256 + wr * 64 + fr;
        if (u.job == 0) {
#pragma unroll
            for (int ai = 0; ai < 2; ++ai)
#pragma unroll
                for (int m = 0; m < 4; ++m) {
                    const int r = rb + ai * 128 + m * 16; const float rs = pre[ai][m];
#pragma unroll
                    for (int bj = 0; bj < 2; ++bj) {
                        const int c = u.pn * 256 + bj * 128 + wc * 32 + fq * 8;
                        f32x4 v0 = acc[ai][bj][m][0] * rs, v1 = acc[ai][bj][m][1] * rs;
                        if (u.pn < 4) { const int g = c >> 4, p0 = c & 15; st_bf16x8(U + ((size_t)g * MT + r) * 16 + p0, v0, v1); }
                        else if (u.pn < 16) {
                            if (u.pn < 6) { v0 = v0 * 0.08838834764831845f; v1 = v1 * 0.08838834764831845f; }
                            if (u.pn >= 12) {
#pragma unroll
                                for (int j = 0; j < 4; ++j) { v0[j] = v0[j] * sigmoid1(v0[j]); v1[j] = v1[j] * sigmoid1(v1[j]); } }
                            st_bf16x8(PROJ + (size_t)r * 3072 + (c - 1024), v0, v1);
                        } else { if (c < 4096 + 16) { *(f32x4*)(GLOW + (size_t)r * 16 + (c - 4096)) = v0; *(f32x4*)(GLOW + (size_t)r * 16 + (c - 4096) + 4) = v1; } }
                    }
                }
        } else if (u.job == 1) {
#pragma unroll
            for (int ai = 0; ai < 2; ++ai)
#pragma unroll
                for (int m = 0; m < 4; ++m) {
                    const int r = rb + ai * 128 + m * 16; const float rs = pre[ai][m];
#pragma unroll
                    for (int bj = 0; bj < 2; ++bj) {
                        const int c = u.pn * 256 + bj * 128 + wc * 32 + fq * 8;
                        const f32x4 v0 = acc[ai][bj][m][0] * rs, v1 = acc[ai][bj][m][1] * rs;
                        if (c < 2048) { float* o = out + O_MK + (size_t)r * 2048 + c; __builtin_nontemporal_store(v0, (f32x4*)o); __builtin_nontemporal_store(v1, (f32x4*)(o + 4)); st_bf16x8(MKB + (size_t)r * 2048 + c, v0, v1); }
                        else { float* o = out + O_MV + (size_t)r * 2048 + (c - 2048); __builtin_nontemporal_store(v0, (f32x4*)o); __builtin_nontemporal_store(v1, (f32x4*)(o + 4)); }
                    }
                }
        } else {
#pragma unroll
            for (int bj = 0; bj < 2; ++bj) {
                const int c = u.pn * 256 + bj * 128 + wc * 32 + fq * 8;
                const f32x4 s0 = *(const f32x4*)(rmem + c), s1 = *(const f32x4*)(rmem + c + 4);
#pragma unroll
                for (int ai = 0; ai < 2; ++ai)
#pragma unroll
                    for (int m = 0; m < 4; ++m) { const int r = rb + ai * 128 + m * 16; st_bf16x8(MVT + (size_t)r * 1024 + c, acc[ai][bj][m][0] * s0, acc[ai][bj][m][1] * s1); }
            }
        }
    }
};

template <bool BB> struct EpiRes {
    const void* baseP; const void* baseS; float* XF; bf16_t* XBo; float* SS; const float* RS; float* SLAB; int nsl;
    __device__ __forceinline__ void prefetch(const pg8::Unit& u, int wr, int fr, float (&pre)[2][4]) const {
#pragma unroll
        for (int ai = 0; ai < 2; ++ai)
#pragma unroll
            for (int m = 0; m < 4; ++m) pre[ai][m] = 1.0f;
    }
    __device__ __forceinline__ void operator()(const AccT& acc, const pg8::Unit& u, int wr, int wc, int fr, int fq, const float (&pre)[2][4]) const {
        if (u.job == 1) { slab_store(acc, u, SLAB, nsl, wr, wc, fr, fq); return; }
        const int rb = u.pm * 256 + wr * 64 + fr;
        const float* basef = (u.pm < 32) ? (const float*)baseP : ((const float*)baseS - (size_t)NPR * DM);
        const bf16_t* baseb = (const bf16_t*)baseP;
        const int c0 = u.pn * 256 + wc * 32 + fq * 8;
        float scl[2][4];
#pragma unroll
        for (int ai = 0; ai < 2; ++ai)
#pragma unroll
            for (int m = 0; m < 4; ++m) scl[ai][m] = RS ? RS[rb + ai * 128 + m * 16] : 1.0f;
        constexpr int MG = BB ? 4 : 2;
#pragma unroll
        for (int ai = 0; ai < 2; ++ai)
#pragma unroll
            for (int mb = 0; mb < 4; mb += MG) {
                u32x4 preb[MG][2]; f32x4 pref[MG][2][2];
#pragma unroll
                for (int mm = 0; mm < MG; ++mm)
#pragma unroll
                    for (int bj = 0; bj < 2; ++bj) {
                        const size_t off = (size_t)(rb + ai * 128 + (mb + mm) * 16) * DM + c0 + bj * 128;
                        if (BB) preb[mm][bj] = *(const u32x4*)(baseb + off);
                        else { pref[mm][bj][0] = __builtin_nontemporal_load((const f32x4*)(basef + off)); pref[mm][bj][1] = __builtin_nontemporal_load((const f32x4*)(basef + off + 4)); }
                    }
#pragma unroll
                for (int mm = 0; mm < MG; ++mm) {
                    const int m = mb + mm, r = rb + ai * 128 + m * 16; float ss = 0.f; const float sc = scl[ai][m];
#pragma unroll
                    for (int bj = 0; bj < 2; ++bj) {
                        const size_t off = (size_t)r * DM + c0 + bj * 128;
                        f32x4 b0, b1;
                        if (BB) { const u32x4 w = preb[mm][bj]; b0 = (f32x4){bflo(w.x), bfhi(w.x), bflo(w.y), bfhi(w.y)}; b1 = (f32x4){bflo(w.z), bfhi(w.z), bflo(w.w), bfhi(w.w)}; }
                        else { b0 = pref[mm][bj][0]; b1 = pref[mm][bj][1]; }
                        const f32x4 v0 = b0 + acc[ai][bj][m][0] * sc, v1 = b1 + acc[ai][bj][m][1] * sc;
                        if (XF) { *(f32x4*)(XF + off) = v0; *(f32x4*)(XF + off + 4) = v1; }
                        if (XBo) st_bf16x8(XBo + off, v0, v1);
                        ss += (v0[0] * v0[0] + v0[1] * v0[1]) + (v0[2] * v0[2] + v0[3] * v0[3]) + (v1[0] * v1[0] + v1[1] * v1[1]) + (v1[2] * v1[2] + v1[3] * v1[3]);
                    }
                    ss += __shfl_xor(ss, 16); ss += __shfl_xor(ss, 32);
                    if (fq == 0) SS[(size_t)r * 32 + u.pn * 4 + wc] = ss;
                }
                asm volatile("" ::: "memory");
            }
    }
};
struct EpiScale {
    const float* RR; bf16_t* O; float scale; float* SLAB; int nsl;
    __device__ __forceinline__ void prefetch(const pg8::Unit& u, int wr, int fr, float (&pre)[2][4]) const {
#pragma unroll
        for (int ai = 0; ai < 2; ++ai)
#pragma unroll
            for (int m = 0; m < 4; ++m) pre[ai][m] = (u.job == 0) ? RR[u.pm * 256 + wr * 64 + fr + ai * 128 + m * 16] : 1.0f;
    }
    __device__ __forceinline__ void operator()(const AccT& acc, const pg8::Unit& u, int wr, int wc, int fr, int fq, const float (&rs)[2][4]) const {
        if (u.job == 1) { slab_store(acc, u, SLAB, nsl, wr, wc, fr, fq); return; }
        const int rb = u.pm * 256 + wr * 64 + fr;
#pragma unroll
        for (int ai = 0; ai < 2; ++ai)
#pragma unroll
            for (int m = 0; m < 4; ++m) { const int r = rb + ai * 128 + m * 16; const float s = rs[ai][m] * scale;
#pragma unroll
                for (int bj = 0; bj < 2; ++bj) { const int c = u.pn * 256 + bj * 128 + wc * 32 + fq * 8; st_bf16x8(O + (size_t)r * DM + c, acc[ai][bj][m][0] * s, acc[ai][bj][m][1] * s); } }
    }
};
__device__ __forceinline__ f32x4 dpp_shr1(f32x4 v) { f32x4 r;
#pragma unroll
    for (int i = 0; i < 4; ++i) r[i] = __int_as_float(__builtin_amdgcn_update_dpp(0, __float_as_int(v[i]), 0x111, 0xf, 0xf, false)); return r; }
__device__ __forceinline__ f32x4 dpp_shr2(f32x4 v) { f32x4 r;
#pragma unroll
    for (int i = 0; i < 4; ++i) r[i] = __int_as_float(__builtin_amdgcn_update_dpp(0, __float_as_int(v[i]), 0x112, 0xf, 0xf, false)); return r; }
__device__ __forceinline__ f32x4 gelu4(f32x4 v) { return (f32x4){gelu1(v[0]), gelu1(v[1]), gelu1(v[2]), gelu1(v[3])}; }
struct EpiUp {
    const float* RR; bf16_t* ACT; float* out; const float* cw; const float* cb; const float* sc; float* HAL; float* HFA; float* HFG;
    __device__ __forceinline__ void prefetch(const pg8::Unit&, int, int, float (&)[2][4]) const {}
    __device__ __forceinline__ void operator()(const AccT& acc, const pg8::Unit& u, int wr, int wc, int fr, int fq, const float (&)[2][4]) const {
        float rs[2][4];
#pragma unroll
        for (int ai = 0; ai < 2; ++ai)
#pragma unroll
            for (int m = 0; m < 4; ++m) rs[ai][m] = RR[u.pm * 256 + wr * 64 + fr + ai * 128 + m * 16];
        float* EX = (float*)(smem + QPRE_OFF);
        int cl = wc * 32 + fq * 8; asm volatile("" : "+v"(cl));
        const int rb = u.pm * 256 + wr * 64 + fr, c = u.pn * 128 + cl;
        const bool sample = (u.pm >= 32);
#pragma unroll
        for (int ai = 0; ai < 2; ++ai)
#pragma unroll
            for (int m = 0; m < 4; ++m) if (fr >= 14) { float* e = EX + (((ai * 8 + wr * 4 + m) * 2 + (fr - 14)) * 128 + cl); *(f32x4*)e = acc[ai][0][m][0] * rs[ai][m]; *(f32x4*)(e + 4) = acc[ai][0][m][1] * rs[ai][m]; }
        float* WT = (float*)(smem + 131072);
        { const int t_ = threadIdx.x; if (t_ < 512) { const int k = t_ >> 7, cc_ = t_ & 127; WT[t_] = (k < 3) ? cw[(size_t)k * DFF + u.pn * 128 + cc_] : cb[u.pn * 128 + cc_]; } }
        asm volatile("s_waitcnt lgkmcnt(0)" ::: "memory"); __builtin_amdgcn_s_barrier(); asm volatile("" ::: "memory");
#pragma unroll
        for (int ai = 0; ai < 2; ++ai)
#pragma unroll
            for (int m = 0; m < 4; ++m) {
                const int r = rb + ai * 128 + m * 16, blk = ai * 8 + wr * 4 + m; const float s = rs[ai][m];
                const f32x4 a0 = acc[ai][0][m][0] * s, a1 = acc[ai][0][m][1] * s, g0 = acc[ai][1][m][0] * s, g1 = acc[ai][1][m][1] * s;
                f32x4 p1a = dpp_shr1(a0), p1b = dpp_shr1(a1), p2a = dpp_shr2(a0), p2b = dpp_shr2(a1);
                bool deferred = false;
                if (!sample) {
                    if (fr < 2) {
                        if (blk > 0) {
                            const float* e = EX + ((blk - 1) * 2) * 128 + cl;
                            const f32x4 x14a = *(const f32x4*)e, x14b = *(const f32x4*)(e + 4), x15a = *(const f32x4*)(e + 128), x15b = *(const f32x4*)(e + 132);
                            if (fr == 0) { p1a = x15a; p1b = x15b; p2a = x14a; p2b = x14b; } else { p2a = x15a; p2b = x15b; }
                        } else if ((u.pm & 7) == 0) {
                            const f32x4 z = (f32x4){0.f, 0.f, 0.f, 0.f};
                            if (fr == 0) { p1a = z; p1b = z; } p2a = z; p2b = z;
                        } else deferred = true;
                    }
                } else {
                    const int j = fr & 3;
                    if (j < 2) { const float* sb = sc + (size_t)((r - NPR) >> 2) * 2 * DFF + c;
                        const f32x4 b1a = __builtin_nontemporal_load((const f32x4*)(sb + DFF)), b1b = __builtin_nontemporal_load((const f32x4*)(sb + DFF + 4));
                        if (j == 0) { p2a = __builtin_nontemporal_load((const f32x4*)sb); p2b = __builtin_nontemporal_load((const f32x4*)(sb + 4)); p1a = b1a; p1b = b1b; } else { p2a = b1a; p2b = b1b; } }
                }
                if (!deferred) {
                    u32x4 ow;
                    { const f32x4 w0a = *(const f32x4*)(WT + cl), w1a = *(const f32x4*)(WT + 128 + cl), w2a = *(const f32x4*)(WT + 256 + cl), cba = *(const f32x4*)(WT + 384 + cl);
                      const f32x4 o0 = gelu4(cba + p2a * w0a + p1a * w1a + a0 * w2a) * g0; ow.x = cvt_pk_bf16(o0[0], o0[1]); ow.y = cvt_pk_bf16(o0[2], o0[3]); }
                    asm volatile("" : "+v"(ow.x), "+v"(ow.y));
                    { const f32x4 w0b = *(const f32x4*)(WT + cl + 4), w1b = *(const f32x4*)(WT + 128 + cl + 4), w2b = *(const f32x4*)(WT + 256 + cl + 4), cbb = *(const f32x4*)(WT + 384 + cl + 4);
                      const f32x4 o1 = gelu4(cbb + p2b * w0b + p1b * w1b + a1 * w2b) * g1; ow.z = cvt_pk_bf16(o1[0], o1[1]); ow.w = cvt_pk_bf16(o1[2], o1[3]); }
                    __builtin_nontemporal_store(ow, (u32x4*)(ACT + (size_t)r * DFF + c));
                } else {
                    float* pa = HFA + ((size_t)u.pm * 2 + fr) * DFF + c; float* pg = HFG + ((size_t)u.pm * 2 + fr) * DFF + c;
                    *(f32x4*)pa = a0; *(f32x4*)(pa + 4) = a1; *(f32x4*)pg = g0; *(f32x4*)(pg + 4) = g1;
                }
                if (!sample && blk == 15 && fr >= 14) { float* ph = HAL + ((size_t)u.pm * 2 + (fr - 14)) * DFF + c; *(f32x4*)ph = a0; *(f32x4*)(ph + 4) = a1; }
                if (r < NPR) { const int t = r & 2047; if (t >= 2046) { float* o = out + O_CONV_P + ((size_t)(r >> 11) * 2 + (t - 2046)) * DFF + c; *(f32x4*)o = a0; *(f32x4*)(o + 4) = a1; } }
                else { const int rsm = r - NPR, j = rsm & 3; if (j >= 2) { float* o = out + O_CONV_S + ((size_t)(rsm >> 2) * 2 + (j - 2)) * DFF + c; *(f32x4*)o = a0; *(f32x4*)(o + 4) = a1; } }
                asm volatile("" ::: "memory");
            }
    }
};

#define XB_TMO      128
#define XB_XCNT(j)  (256  + 64 * (j))
#define XB_XSUB(j)  (1280 + 64 * (j))
#define XB_XGEN(j)  (2304 + 64 * (j))
#define XB_TOP      3328
#define XB_TOPGEN   3392
#define XCD_BAR_WORDS 3456
#define XB_SPIN_CAP (1u << 18)
__device__ __forceinline__ unsigned xb_ld(unsigned* p)              { return __hip_atomic_load(p, __ATOMIC_RELAXED, __HIP_MEMORY_SCOPE_AGENT); }
__device__ __forceinline__ unsigned xb_add(unsigned* p, unsigned v) { return __hip_atomic_fetch_add(p, v, __ATOMIC_RELAXED, __HIP_MEMORY_SCOPE_AGENT); }
__device__ __forceinline__ unsigned xb_xcc_id() { return (unsigned)__builtin_amdgcn_s_getreg((3 << 11) | 20) & 0xFu; }
#define XB_SPIN(cond, bar) do { unsigned _sp = 0; while (cond) { __builtin_amdgcn_s_sleep(1); \
    if ((++_sp & 255u) == 0u) { if (xb_ld(&(bar)[XB_TMO])) break; if (_sp > XB_SPIN_CAP) { atomicAdd(&(bar)[XB_TMO], 1u); break; } } } } while (0)
struct XcdBarrier { unsigned* bar; unsigned x; volatile LAS unsigned* st; };
__device__ __forceinline__ XcdBarrier xcd_barrier_post(unsigned* bar, volatile LAS unsigned* st) {
    XcdBarrier b; b.bar = bar; b.x = xb_xcc_id(); b.st = st;
    if (threadIdx.x == 0) (void)xb_add(&bar[XB_XCNT(b.x)], 1u);
    return b;
}
__device__ __forceinline__ void xcd_barrier_complete(unsigned* bar, unsigned x, unsigned& nloc, unsigned& nx) {
    const unsigned G = gridDim.x * gridDim.y * gridDim.z;
    unsigned sum, cnt, mine, sp = 0u;
    for (;;) {
        sum = 0u; cnt = 0u; mine = 0u;
#pragma unroll
        for (unsigned j = 0; j < 16; ++j) { const unsigned c = xb_ld(&bar[XB_XCNT(j)]); sum += c; cnt += (c > 0u) ? 1u : 0u; mine = (j == x) ? c : mine; }
        if (sum == G) break;
        __builtin_amdgcn_s_sleep(1);
        if ((++sp & 255u) == 0u) { if (xb_ld(&bar[XB_TMO])) break; if (sp > XB_SPIN_CAP) { atomicAdd(&bar[XB_TMO], 1u); break; } }
    }
    nloc = mine > 0u ? mine : 1u; nx = cnt > 0u ? cnt : 1u;
}
__device__ __forceinline__ void xcd_barrier(const XcdBarrier& b) {
    asm volatile("s_waitcnt vmcnt(0)" ::: "memory");
    __syncthreads();
    if (threadIdx.x == 0) {
        unsigned* bar = b.bar;
        __builtin_amdgcn_s_waitcnt(0);
        unsigned nloc = b.st[0], nx = b.st[1];
        if (nloc == 0u) { xcd_barrier_complete(bar, b.x, nloc, nx); b.st[0] = nloc; b.st[1] = nx; }
        const unsigned old = xb_add(&bar[XB_XSUB(b.x)], 1u);
        const unsigned gen = old / nloc;
        if (old + 1u == (gen + 1u) * nloc) {
            __builtin_amdgcn_fence(__ATOMIC_RELEASE, "agent");
            asm volatile("s_waitcnt vmcnt(0)" ::: "memory");
            const unsigned og = xb_add(&bar[XB_TOP], 1u);
            const unsigned tg = og / nx;
            if (og + 1u == (tg + 1u) * nx) xb_add(&bar[XB_TOPGEN], 1u);
            else XB_SPIN(xb_ld(&bar[XB_TOPGEN]) == tg, bar);
            __builtin_amdgcn_fence(__ATOMIC_ACQUIRE, "agent");
            xb_add(&bar[XB_XGEN(b.x)], 1u);
            asm volatile("s_waitcnt vmcnt(0)" ::: "memory");
        } else {
            XB_SPIN(xb_ld(&bar[XB_XGEN(b.x)]) == gen, bar);
            __builtin_amdgcn_fence(__ATOMIC_ACQUIRE, "agent");
            asm volatile("s_waitcnt vmcnt(0)" ::: "memory");
        }
    }
    __syncthreads();
}

extern __shared__ __attribute__((aligned(16))) unsigned char smem[];
#define LDS_WAIT() asm volatile("s_waitcnt lgkmcnt(0)" ::: "memory")

__device__ __forceinline__ int rowmap(int mat, int n) {
    if (mat == 0) return n < 3072 ? n : (n < 3088 ? 4096 + (n - 3072) : n - 16);
    if (mat == 6) { if (n < DFF) return (n >> 7) * 256 + (n & 127); const int q = n - DFF; return (q >> 7) * 256 + 128 + (q & 127); }
    return n;
}
__device__ __forceinline__ void transpose_item(const float* __restrict__ W, int K, int N, const float* __restrict__ gain, int glim, bf16_t* __restrict__ Wt, int mat, float* scr, int item, int lane) {
    const int nblk = (N + 63) / 64, kb = item / nblk, nb = item % nblk, k0 = 64 * kb, n0 = 64 * nb;
    const int n4 = (lane & 15) * 4; const bool inb = (n0 + n4 < N);
    f32x4 v[16]; float gsc[16];
#pragma unroll
    for (int i = 0; i < 16; ++i) { const int k = 4 * i + (lane >> 4);
        v[i] = inb ? __builtin_nontemporal_load((const f32x4*)(W + (size_t)(k0 + k) * N + n0 + n4)) : (f32x4){0.f, 0.f, 0.f, 0.f};
        gsc[i] = (gain != nullptr && (k0 + k) < glim) ? gain[k0 + k] : 1.0f; }
#pragma unroll
    for (int i = 0; i < 16; ++i) { const int k = 4 * i + (lane >> 4); float* s = scr + k * 65 + n4; s[0] = v[i][0] * gsc[i]; s[1] = v[i][1] * gsc[i]; s[2] = v[i][2] * gsc[i]; s[3] = v[i][3] * gsc[i]; }
    LDS_WAIT(); asm volatile("" ::: "memory");
#pragma unroll
    for (int j = 0; j < 8; ++j) {
        const int idx = lane + 64 * j, n = idx >> 3, c = idx & 7; const float* s = scr + (8 * c) * 65 + n;
        u32x4 o; o.x = cvt_pk_bf16(s[0], s[65]); o.y = cvt_pk_bf16(s[130], s[195]); o.z = cvt_pk_bf16(s[260], s[325]); o.w = cvt_pk_bf16(s[390], s[455]);
        if (n0 + n < N) *(u32x4*)(Wt + (size_t)rowmap(mat, n0 + n) * K + k0 + 8 * c) = o;
    }
    LDS_WAIT(); asm volatile("" ::: "memory");
}
__device__ __forceinline__ void row_to_bf16(const float* __restrict__ xrow, bf16_t* __restrict__ orow, float* rout, int lane) {
    f32x4 v[8]; float s = 0.f;
#pragma unroll
    for (int j = 0; j < 8; ++j) { v[j] = __builtin_nontemporal_load((const f32x4*)xrow + lane + 64 * j); s += (v[j][0] * v[j][0] + v[j][1] * v[j][1]) + (v[j][2] * v[j][2] + v[j][3] * v[j][3]); }
    s = wave_sum(s);
    if (lane == 0) *rout = rsqrtf(s * (1.0f / 2048.0f) + EPS);
#pragma unroll
    for (int j = 0; j < 8; ++j) { u32x2 w; w.x = cvt_pk_bf16(v[j][0], v[j][1]); w.y = cvt_pk_bf16(v[j][2], v[j][3]); ((u32x2*)orow)[lane + 64 * j] = w; }
}
__device__ __forceinline__ void s5_tables(const Args& a, int g, int part, int tid) {
    float* L = (float*)smem; float* PWR = L; float* PWI = L + 1088; float* BBR = L + 2176; float* BBI = BBR + 1024; float* CR = BBI + 1024; float* CI = CR + 1024;
    unsigned char* ws = a.ws;
    bf16_t* KT = (bf16_t*)(ws + WS_KT) + (size_t)g * 4096; bf16_t* M2T = (bf16_t*)(ws + WS_M2T) + (size_t)g * 32768; bf16_t* M3T = (bf16_t*)(ws + WS_M3T) + (size_t)g * 32768;
    float* A16 = (float*)(ws + WS_A16); float* A4 = (float*)(ws + WS_A4);
    const float dt = expf(a.in[13][g]);
    if (tid < 64) {
        const int n = tid; const float lr = a.in[11][g * 64 + n], li = a.in[12][g * 64 + n];
        const float mag = expf(lr * dt), ar = mag * cosf(li * dt), ai = mag * sinf(li * dt);
        const float den = lr * lr + li * li, pr = ar - 1.0f, qr = (pr * lr + ai * li) / den, qi = (ai * lr - pr * li) / den;
        float cr_ = 1.f, ci_ = 0.f;
        for (int d = 0; d <= 16; ++d) { PWR[d * 64 + n] = cr_; PWI[d * 64 + n] = ci_;
            if (part == 0 && d == 4) { A4[(g * 64 + n) * 2] = cr_; A4[(g * 64 + n) * 2 + 1] = ci_; }
            if (part == 0 && d == 16) { A16[(g * 64 + n) * 2] = cr_; A16[(g * 64 + n) * 2 + 1] = ci_; }
            const float t_ = cr_ * ar - ci_ * ai; ci_ = cr_ * ai + ci_ * ar; cr_ = t_; }
        for (int p = 0; p < 16; ++p) { const float br = a.in[14][(g * 64 + n) * 16 + p], bi = a.in[15][(g * 64 + n) * 16 + p]; BBR[n * 16 + p] = qr * br - qi * bi; BBI[n * 16 + p] = qr * bi + qi * br; }
    }
    for (int i = tid; i < 1024; i += 512) { CR[i] = a.in[16][g * 1024 + i]; CI[i] = a.in[17][g * 1024 + i]; }
    __syncthreads();
    if (part == 0 || part == 3) {
        for (int e = (part == 0 ? 0 : 2048) + tid; e < (part == 0 ? 2048 : 4096); e += 512) {
            const int d = e >> 8, p = (e >> 4) & 15, q = e & 15; float s = 0.f;
            for (int n = 0; n < 64; ++n) { const float pwr = PWR[d * 64 + n], pwi = PWI[d * 64 + n], bbr = BBR[n * 16 + q], bbi = BBI[n * 16 + q];
                const float er = pwr * bbr - pwi * bbi, ei = pwr * bbi + pwi * bbr; s += CR[p * 64 + n] * er - CI[p * 64 + n] * ei; }
            if (d == 0 && p == q) s += a.in[18][g * 16 + p];
            KT[e] = f2bf(s);
        }
    } else if (part == 1) {
        for (int it = tid; it < 4096; it += 512) {
            const int np = it >> 5, s_ = (it >> 1) & 15, q0 = (it & 1) * 8, n = np & 63, d = 15 - s_;
            const float pwr = PWR[d * 64 + n], pwi = PWI[d * 64 + n]; float o[8];
#pragma unroll
            for (int j = 0; j < 8; ++j) { const float bbr = BBR[n * 16 + q0 + j], bbi = BBI[n * 16 + q0 + j]; o[j] = np < 64 ? (pwr * bbr - pwi * bbi) : (pwr * bbi + pwi * bbr); }
            *(u32x4*)(M2T + (size_t)np * 256 + s_ * 16 + q0) = (u32x4){cvt_pk_bf16(o[0], o[1]), cvt_pk_bf16(o[2], o[3]), cvt_pk_bf16(o[4], o[5]), cvt_pk_bf16(o[6], o[7])};
        }
    } else {
        for (int it = tid; it < 4096; it += 512) {
            const int row = it >> 4, np0 = (it & 15) * 8, p = row >> 4, t = row & 15; float o[8];
#pragma unroll
            for (int j = 0; j < 8; ++j) { const int np = np0 + j, n = np & 63; const float ar = PWR[(t + 1) * 64 + n], ai = PWI[(t + 1) * 64 + n], cr = CR[p * 64 + n], ci = CI[p * 64 + n];
                o[j] = np < 64 ? (cr * ar - ci * ai) : -(cr * ai + ci * ar); }
            *(u32x4*)(M3T + (size_t)row * 128 + np0) = (u32x4){cvt_pk_bf16(o[0], o[1]), cvt_pk_bf16(o[2], o[3]), cvt_pk_bf16(o[4], o[5]), cvt_pk_bf16(o[6], o[7])};
        }
    }
    __syncthreads();
}
constexpr int TR_I0 = 32 * 65, TR_ISQ = 32 * 32, TR_I6 = 32 * 176, TR_I7 = 88 * 32;
constexpr int TR_NITEMS = TR_I0 + 5 * TR_ISQ + TR_I6 + TR_I7, TR_DEFER = TR_I7 + TR_I6;
__device__ __forceinline__ void transpose_dispatch(const Args& a, int it, float* scr, int lane) {
    unsigned char* ws = a.ws; bf16_t* WIN = (bf16_t*)(ws + WS_WIN); bf16_t* WXKV = (bf16_t*)(ws + WS_WXKV);
    int r = it;
    if (r < TR_I0) { transpose_item(a.in[10], 2048, 4112, a.in[9], 2048, WIN, 0, scr, r, lane); return; } r -= TR_I0;
    if (r < TR_ISQ) { transpose_item(a.in[25], 2048, 2048, a.in[21], 1024, (bf16_t*)(ws + WS_WOUT), 1, scr, r, lane); return; } r -= TR_ISQ;
    if (r < TR_ISQ) { transpose_item(a.in[28], 2048, 2048, a.in[26], 2048, (bf16_t*)(ws + WS_WXQ), 2, scr, r, lane); return; } r -= TR_ISQ;
    if (r < TR_ISQ) { transpose_item(a.in[29], 2048, 2048, a.in[27], 2048, WXKV, 3, scr, r, lane); return; } r -= TR_ISQ;
    if (r < TR_ISQ) { transpose_item(a.in[30], 2048, 2048, a.in[27], 2048, WXKV + (size_t)2048 * 2048, 4, scr, r, lane); return; } r -= TR_ISQ;
    if (r < TR_ISQ) { transpose_item(a.in[31], 2048, 2048, nullptr, 0, (bf16_t*)(ws + WS_WXO), 5, scr, r, lane); return; } r -= TR_ISQ;
    if (r < TR_I6) { transpose_item(a.in[33], 2048, 11264, a.in[32], 2048, (bf16_t*)(ws + WS_WUP), 6, scr, r, lane); return; } r -= TR_I6;
    transpose_item(a.in[36], 5632, 2048, nullptr, 0, (bf16_t*)(ws + WS_WDN), 7, scr, r, lane);
}
__device__ __forceinline__ void p0_prologue(const Args& a, int bx, int G, int tid, int wave, int lane) {
    unsigned char* ws = a.ws;
    float* scr = (float*)smem + wave * 4160;
    const int gw = bx * NWAVES + wave, NGW = G * NWAVES; bf16_t* WIN = (bf16_t*)(ws + WS_WIN);
    for (int it = gw; it < TR_NITEMS - TR_DEFER; it += NGW) transpose_dispatch(a, it, scr, lane);
    { u32x4* z = (u32x4*)(WIN + (size_t)4112 * 2048); const int nz = 240 * 2048 / 8;
      for (int i = bx * 512 + tid; i < nz; i += G * 512) z[i] = (u32x4){0u, 0u, 0u, 0u}; }
    bf16_t* XB = (bf16_t*)(ws + WS_XB); bf16_t* MEMB = (bf16_t*)(ws + WS_MEMB); float* R1 = (float*)(ws + WS_R1); float* RMEM = (float*)(ws + WS_RMEM);
    for (int m = gw; m < MT + NMEMR; m += NGW) {
        if (m < NPR) row_to_bf16(a.in[0] + (size_t)m * DM, XB + (size_t)m * DM, R1 + m, lane);
        else if (m < MT) row_to_bf16(a.in[1] + (size_t)(m - NPR) * DM, XB + (size_t)m * DM, R1 + m, lane);
        else row_to_bf16(a.in[2] + (size_t)(m - MT) * DM, MEMB + (size_t)(m - MT) * DM, RMEM + (m - MT), lane);
    }
    __syncthreads();
    for (int t = bx; t < 256; t += G) s5_tables(a, t & 63, t >> 6, tid);
}

__device__ __forceinline__ float gelu_v(float v) { return gelu1(v); }
__device__ __forceinline__ f32x4 gelu_v(f32x4 v) { return (f32x4){gelu1(v[0]), gelu1(v[1]), gelu1(v[2]), gelu1(v[3])}; }
__device__ __forceinline__ float sigm_v(float v) { return sigmoid1(v); }
__device__ __forceinline__ f32x4 sigm_v(f32x4 v) { return (f32x4){sigmoid1(v[0]), sigmoid1(v[1]), sigmoid1(v[2]), sigmoid1(v[3])}; }
__device__ __forceinline__ float vget(float v, int) { return v; }
__device__ __forceinline__ float vget(f32x4 v, int i) { return v[i]; }
template <class T, int NV>
__device__ __forceinline__ void s5_glu(T (&y)[16], const float* WL, unsigned (&pk)[NV][8], T& ss) {
#pragma unroll
    for (int p = 0; p < 16; ++p) y[p] = gelu_v(y[p]);
    ss = y[0] * 0.f;
    T prev = ss;
#pragma unroll
    for (int q = 0; q < 16; ++q) {
        T gq = ss * 0.f + WL[256 + q];
        const f32x4 w0 = *(const f32x4*)(WL + q * 16), w1 = *(const f32x4*)(WL + q * 16 + 4), w2 = *(const f32x4*)(WL + q * 16 + 8), w3 = *(const f32x4*)(WL + q * 16 + 12);
#pragma unroll
        for (int p = 0; p < 4; ++p) { gq += y[p] * w0[p]; gq += y[4 + p] * w1[p]; gq += y[8 + p] * w2[p]; gq += y[12 + p] * w3[p]; }
        const T o = y[q] * sigm_v(gq); ss += o * o;
        if (q & 1) {
#pragma unroll
            for (int v = 0; v < NV; ++v) pk[v][q >> 1] = cvt_pk_bf16(vget(prev, v), vget(o, v)); }
        prev = o;
        asm volatile("" ::: "memory");
    }
}

__device__ __forceinline__ void s5_prompt_task(const Args& a, int b, int g, int tid, int w, int lane) {
    unsigned char* ws = a.ws; const int fr = lane & 15, fq = lane >> 4;
    bf16_t* MB = (bf16_t*)smem;
    float* Zs = (float*)smem;
    bf16_t* Hp = (bf16_t*)(smem + 69632);
    float* SE = (float*)(smem + 104448);
    float* WL = (float*)(smem + 108544);
    bf16_t* KL = (bf16_t*)(smem + 109632);
    const bf16_t* Ubg = (const bf16_t*)(ws + WS_U) + ((size_t)g * MT + (size_t)b * 2048) * 16;
    const bf16_t* M2 = (const bf16_t*)(ws + WS_M2T) + (size_t)g * 32768;
    const bf16_t* M3 = (const bf16_t*)(ws + WS_M3T) + (size_t)g * 32768;
    const bf16_t* KTg = (const bf16_t*)(ws + WS_KT) + (size_t)g * 4096;
    if (tid < 256) WL[tid] = a.in[19][g * 256 + (tid & 15) * 16 + (tid >> 4)]; else if (tid < 272) WL[tid] = a.in[20][g * 16 + (tid - 256)];
    {
        u32x4 t[8];
#pragma unroll
        for (int i = 0; i < 8; ++i) t[i] = *(const u32x4*)(M2 + (size_t)(tid + 512 * i) * 8);
        const u32x4 kt = *(const u32x4*)(KTg + tid * 8);
#pragma unroll
        for (int i = 0; i < 8; ++i) { const int idx = tid + 512 * i, rr = idx >> 5, ch = idx & 31; *(u32x4*)(MB + rr * 264 + ch * 8) = t[i]; }
        { const int d = tid >> 5, p = (tid >> 1) & 15, q0 = (tid & 1) * 8; *(u32x4*)(KL + (p * 16 + d) * 16 + q0) = kt; }
    }
    bf16x8 ua[8];
#pragma unroll
    for (int ks = 0; ks < 8; ++ks) ua[ks] = ldg8(Ubg + (size_t)(16 * w + fr) * 256 + 32 * ks + 8 * fq);
    __syncthreads();
    {
        f32x4 acc[8];
#pragma unroll
        for (int nt = 0; nt < 8; ++nt) acc[nt] = (f32x4){0.f, 0.f, 0.f, 0.f};
#pragma unroll
        for (int nt = 0; nt < 8; ++nt)
#pragma unroll
            for (int ks = 0; ks < 8; ++ks) acc[nt] = mma16(*(const bf16x8*)(MB + (16 * nt + fr) * 264 + 32 * ks + 8 * fq), ua[ks], acc[nt]);
        __syncthreads();
#pragma unroll
        for (int nt = 0; nt < 8; ++nt) *(f32x4*)(Zs + (16 * w + fr) * 128 + 16 * nt + 4 * fq) = acc[nt];
    }
    u32x4 m3r[8];
#pragma unroll
    for (int i = 0; i < 8; ++i) m3r[i] = *(const u32x4*)(M3 + (size_t)(tid + 512 * i) * 8);
    __syncthreads();
    {
        const int n = lane, seg = w;
        const float* A16 = (const float*)(ws + WS_A16) + (g * 64 + n) * 2; const float ar = A16[0], ai = A16[1];
        float hr = 0.f, hi = 0.f; float lr[16], li[16];
#pragma unroll
        for (int j = 0; j < 16; ++j) { lr[j] = hr; li[j] = hi; const float zr = Zs[(16 * seg + j) * 128 + n], zi = Zs[(16 * seg + j) * 128 + 64 + n];
            const float t_ = ar * hr - ai * hi + zr; hi = ar * hi + ai * hr + zi; hr = t_; }
        SE[seg * 128 + n] = hr; SE[seg * 128 + 64 + n] = hi;
        __syncthreads();
        float br = ar, bi = ai;
#pragma unroll
        for (int k = 0; k < 4; ++k) { const float t_ = br * br - bi * bi; bi = 2.f * br * bi; br = t_; }
        float cr = 0.f, ci = 0.f;
        for (int s = 0; s < seg; ++s) { const float er = SE[s * 128 + n], ei = SE[s * 128 + 64 + n]; const float t_ = br * cr - bi * ci + er; ci = br * ci + bi * cr + ei; cr = t_; }
        float pr = 1.f, pi = 0.f;
#pragma unroll
        for (int j = 0; j < 16; ++j) { const float Hr = lr[j] + pr * cr - pi * ci, Hi = li[j] + pr * ci + pi * cr;
            Hp[(16 * seg + j) * 136 + n] = f2bf(Hr); Hp[(16 * seg + j) * 136 + 64 + n] = f2bf(Hi);
            const float t_ = pr * ar - pi * ai; pi = pr * ai + pi * ar; pr = t_; }
        if (seg == 7) { float* o = a.out; o[O_S5RE_P + (size_t)(b * 64 + g) * 64 + n] = hr + pr * cr - pi * ci; o[O_S5IM_P + (size_t)(b * 64 + g) * 64 + n] = hi + pr * ci + pi * cr; }
    }
    __syncthreads();
#pragma unroll
    for (int i = 0; i < 8; ++i) { const int idx = tid + 512 * i, rr = idx >> 4, ch = idx & 15; *(u32x4*)(MB + rr * 136 + ch * 8) = m3r[i]; }
    __syncthreads();
    {
        f32x4 acc[16];
#pragma unroll
        for (int p = 0; p < 16; ++p) acc[p] = (f32x4){0.f, 0.f, 0.f, 0.f};
#pragma unroll
        for (int ks = 0; ks < 8; ++ks) {
            const int s = 2 * ks + (fq >> 1), q0 = 8 * (fq & 1), d = fr - s; const int dd = d < 0 ? 0 : d;
#pragma unroll
            for (int p = 0; p < 16; ++p) { bf16x8 bfr = *(const bf16x8*)(KL + (p * 16 + dd) * 16 + q0); if (d < 0) bfr = (bf16x8){0, 0, 0, 0, 0, 0, 0, 0}; acc[p] = mma16(bfr, ua[ks], acc[p]); }
        }
#pragma unroll
        for (int ks = 0; ks < 4; ++ks) {
            const bf16x8 af = *(const bf16x8*)(Hp + (16 * w + fr) * 136 + 32 * ks + 8 * fq);
#pragma unroll
            for (int p = 0; p < 16; ++p) acc[p] = mma16(*(const bf16x8*)(MB + (p * 16 + fr) * 136 + 32 * ks + 8 * fq), af, acc[p]);
        }
        bf16_t* YC = (bf16_t*)(ws + WS_YCAT); float* S5SS = (float*)(ws + WS_S5SS);
        unsigned pk[4][8]; f32x4 ss;
        s5_glu<f32x4, 4>(acc, WL, pk, ss);
#pragma unroll
        for (int r = 0; r < 4; ++r) {
            const size_t row = (size_t)b * 2048 + (size_t)(16 * w + fr) * 16 + 4 * fq + r;
            *(u32x4*)(YC + row * 2048 + g * 16) = (u32x4){pk[r][0], pk[r][1], pk[r][2], pk[r][3]};
            *(u32x4*)(YC + row * 2048 + g * 16 + 8) = (u32x4){pk[r][4], pk[r][5], pk[r][6], pk[r][7]};
            S5SS[row * 64 + g] = ss[r];
        }
    }
    __syncthreads();
}
__device__ __forceinline__ void s5_sample_task(const Args& a, int g, int tid, int w, int lane) {
    unsigned char* ws = a.ws; const int fr = lane & 15, fq = lane >> 4; const int bb = 16 * w + fr;
    const bf16_t* Us = (const bf16_t*)(ws + WS_U) + ((size_t)g * MT + NPR) * 16;
    const bf16_t* M2 = (const bf16_t*)(ws + WS_M2T) + (size_t)g * 32768;
    const bf16_t* M3 = (const bf16_t*)(ws + WS_M3T) + (size_t)g * 32768;
    const bf16_t* KTg = (const bf16_t*)(ws + WS_KT) + (size_t)g * 4096;
    const float* h0r = a.in[5] + ((size_t)bb * 64 + g) * 64; const float* h0i = a.in[6] + ((size_t)bb * 64 + g) * 64;
    float* WL = (float*)smem;
    if (tid < 256) WL[tid] = a.in[19][g * 256 + (tid & 15) * 16 + (tid >> 4)]; else if (tid < 272) WL[tid] = a.in[20][g * 16 + (tid - 256)];
    __syncthreads();
    bf16x8 ua[2], ha[4];
#pragma unroll
    for (int ks = 0; ks < 2; ++ks) ua[ks] = ldg8(Us + (size_t)bb * 64 + 32 * ks + 8 * fq);
#pragma unroll
    for (int ks = 0; ks < 4; ++ks) { const int np = 32 * ks + 8 * fq; const float* src = (np < 64 ? h0r + np : h0i + (np - 64)); ha[ks] = pack8(*(const f32x4*)src, *(const f32x4*)(src + 4)); }
    f32x4 acc[4];
#pragma unroll
    for (int nt = 0; nt < 4; ++nt) acc[nt] = (f32x4){0.f, 0.f, 0.f, 0.f};
    const int tB = fr >> 2, pB = fr & 3;
#pragma unroll
    for (int ks = 0; ks < 2; ++ks) {
        const int s = 2 * ks + (fq >> 1), q0 = 8 * (fq & 1), d = tB - s; const int dd = d < 0 ? 0 : d;
#pragma unroll
        for (int nt = 0; nt < 4; ++nt) { bf16x8 bfr = ldg8(KTg + (dd * 16 + 4 * nt + pB) * 16 + q0); if (d < 0) bfr = (bf16x8){0, 0, 0, 0, 0, 0, 0, 0}; acc[nt] = mma16(bfr, ua[ks], acc[nt]); }
    }
#pragma unroll
    for (int ks = 0; ks < 4; ++ks)
#pragma unroll
        for (int nt = 0; nt < 4; ++nt) acc[nt] = mma16(ldg8(M3 + (size_t)((4 * nt + pB) * 16 + tB) * 128 + 32 * ks + 8 * fq), ha[ks], acc[nt]);
    {
        float y[16];
#pragma unroll
        for (int nt = 0; nt < 4; ++nt)
#pragma unroll
            for (int r = 0; r < 4; ++r) y[4 * nt + r] = acc[nt][r];
        const size_t row = (size_t)NPR + 4 * bb + fq;
        unsigned pk[1][8]; float ss;
        s5_glu<float, 1>(y, WL, pk, ss);
        bf16_t* dst = (bf16_t*)(ws + WS_YCAT) + row * 2048 + g * 16;
        *(u32x4*)dst = (u32x4){pk[0][0], pk[0][1], pk[0][2], pk[0][3]}; *(u32x4*)(dst + 8) = (u32x4){pk[0][4], pk[0][5], pk[0][6], pk[0][7]};
        ((float*)(ws + WS_S5SS))[row * 64 + g] = ss;
    }
    f32x4 ac2[8];
#pragma unroll
    for (int nt = 0; nt < 8; ++nt) ac2[nt] = (f32x4){0.f, 0.f, 0.f, 0.f};
#pragma unroll
    for (int ks = 0; ks < 2; ++ks)
#pragma unroll
        for (int nt = 0; nt < 8; ++nt) ac2[nt] = mma16(ldg8(M2 + (size_t)(16 * nt + fr) * 256 + 192 + 32 * ks + 8 * fq), ua[ks], ac2[nt]);
    const float* A4 = (const float*)(ws + WS_A4) + (size_t)g * 128;
#pragma unroll
    for (int nt = 0; nt < 4; ++nt) {
        const int n0 = 16 * nt + 4 * fq;
        const f32x4 hr = *(const f32x4*)(h0r + n0), hi = *(const f32x4*)(h0i + n0);
        const f32x4 c0 = *(const f32x4*)(A4 + 2 * n0), c1 = *(const f32x4*)(A4 + 2 * n0 + 4);
        const float ar[4] = {c0[0], c0[2], c1[0], c1[2]}, ai[4] = {c0[1], c0[3], c1[1], c1[3]};
        f32x4 orr, oii;
#pragma unroll
        for (int r = 0; r < 4; ++r) { orr[r] = ar[r] * hr[r] - ai[r] * hi[r] + ac2[nt][r]; oii[r] = ar[r] * hi[r] + ai[r] * hr[r] + ac2[nt + 4][r]; }
        *(f32x4*)(a.out + O_S5RE_S + ((size_t)bb * 64 + g) * 64 + n0) = orr;
        *(f32x4*)(a.out + O_S5IM_S + ((size_t)bb * 64 + g) * 64 + n0) = oii;
    }
    __syncthreads();
}

__device__ __forceinline__ void gla_a_task(const Args& a, int task, int tid, int w, int lane) {
    unsigned char* ws = a.ws; const int fr = lane & 15, fq = lane >> 4;
    const int b = task >> 7, h = (task >> 5) & 3, c = task & 31;
    bf16_t* QT = (bf16_t*)smem;
    bf16_t* KTt = (bf16_t*)(smem + 17408);
    bf16_t* KET = (bf16_t*)(smem + 34816);
    bf16_t* VT = (bf16_t*)(smem + 53248);
    bf16_t* PM = (bf16_t*)(smem + 90112);
    float* CS = (float*)(smem + 99328);
    const bf16_t* PROJ = (const bf16_t*)(ws + WS_PROJ); const float* GLOW = (const float*)(ws + WS_GLOW);
    bf16_t* OG = (bf16_t*)(ws + WS_OG); bf16_t* KVC = (bf16_t*)(ws + WS_KVC) + (size_t)task * 32768; bf16_t* QTG = (bf16_t*)(ws + WS_QTG) + (size_t)task * 8192;
    float* DECG = (float*)(ws + WS_DECG) + (size_t)task * 128;
    const int dk = tid & 127, tq = tid >> 7;
    const size_t rowc = (size_t)b * 2048 + (size_t)c * 64;
    bf16_t* RQ = (bf16_t*)(smem + 101376);
    bf16_t* RK = (bf16_t*)(smem + 117760);
    float* GL = (float*)(smem + 134144);
    {
        u32x4 tq_[2], tk_[2]; f32x4 tg = (f32x4){0.f, 0.f, 0.f, 0.f};
#pragma unroll
        for (int i = 0; i < 2; ++i) { const int idx = tid + 512 * i, rr = idx >> 4, ch = idx & 15; const bf16_t* src = PROJ + (rowc + rr) * 3072 + h * 128 + ch * 8; tq_[i] = *(const u32x4*)src; tk_[i] = *(const u32x4*)(src + 512); }
        if (tid < 256) tg = *(const f32x4*)(GLOW + rowc * 16 + tid * 4);
#pragma unroll
        for (int i = 0; i < 2; ++i) { const int idx = tid + 512 * i; *(u32x4*)(RQ + idx * 8) = tq_[i]; *(u32x4*)(RK + idx * 8) = tk_[i]; }
        if (tid < 256) *(f32x4*)(GL + tid * 4) = tg;
    }
    float wg[16];
#pragma unroll
    for (int j = 0; j < 16; ++j) wg[j] = a.in[22][j * 512 + h * 128 + dk];
    const float bg = a.in[23][h * 128 + dk];
    __syncthreads();
    float lcs[16]; float run = 0.f;
#pragma unroll
    for (int i = 0; i < 16; ++i) {
        const float* gl = GL + (16 * tq + i) * 16;
        const f32x4 g0 = *(const f32x4*)gl, g1 = *(const f32x4*)(gl + 4), g2 = *(const f32x4*)(gl + 8), g3 = *(const f32x4*)(gl + 12);
        float z = bg;
#pragma unroll
        for (int j = 0; j < 4; ++j) { z += g0[j] * wg[j]; z += g1[j] * wg[4 + j]; z += g2[j] * wg[8 + j]; z += g3[j] * wg[12 + j]; }
        run += (fminf(z, 0.f) - __logf(1.0f + __expf(-fabsf(z)))) * 0.0625f; lcs[i] = run;
    }
    CS[tq * 128 + dk] = run;
    __syncthreads();
    float pre = 0.f, tot = 0.f;
#pragma unroll
    for (int q = 0; q < 4; ++q) { const float v = CS[q * 128 + dk]; tot += v; if (q < tq) pre += v; }
    {
        unsigned kep[8];
#pragma unroll
        for (int i = 0; i < 16; i += 2) {
            float kes[2];
#pragma unroll
            for (int e = 0; e < 2; ++e) {
                const int t = 16 * tq + i + e; const float bc = pre + lcs[i + e];
                const float qv = bf2f(RQ[t * 128 + dk]), kv = bf2f(RK[t * 128 + dk]);
                QT[t * 136 + dk] = f2bf(qv * __expf(bc)); KTt[t * 136 + dk] = f2bf(kv * __expf(-bc)); kes[e] = kv * __expf(tot - bc);
            }
            kep[i >> 1] = cvt_pk_bf16(kes[0], kes[1]);
        }
        *(u32x4*)(KET + dk * 72 + 16 * tq) = (u32x4){kep[0], kep[1], kep[2], kep[3]};
        *(u32x4*)(KET + dk * 72 + 16 * tq + 8) = (u32x4){kep[4], kep[5], kep[6], kep[7]};
        if (tq == 0) DECG[dk] = __expf(tot);
        const int dv = tid & 255, sh = tid >> 8;
        unsigned vp[16];
#pragma unroll
        for (int i = 0; i < 32; i += 2) {
            const bf16_t v0 = PROJ[(rowc + 32 * sh + i) * 3072 + 1024 + h * 256 + dv], v1 = PROJ[(rowc + 32 * sh + i + 1) * 3072 + 1024 + h * 256 + dv];
            vp[i >> 1] = (unsigned)v0 | ((unsigned)v1 << 16);
        }
#pragma unroll
        for (int i = 0; i < 4; ++i) *(u32x4*)(VT + dv * 72 + 32 * sh + 8 * i) = (u32x4){vp[4 * i], vp[4 * i + 1], vp[4 * i + 2], vp[4 * i + 3]};
    }
    __syncthreads();
    {
#pragma unroll
        for (int i = 0; i < 2; ++i) { const int idx = tid + 512 * i, rr = idx >> 4, ch = idx & 15; *(u32x4*)(QTG + rr * 128 + ch * 8) = *(const u32x4*)(QT + rr * 136 + ch * 8); }
        const int mt = w & 3;
#pragma unroll
        for (int e = 0; e < 2; ++e) {
            const int nt = 2 * (w >> 2) + e; f32x4 sc = (f32x4){0.f, 0.f, 0.f, 0.f};
            if (nt <= mt) {
#pragma unroll
                for (int ks = 0; ks < 4; ++ks) sc = mma16(*(const bf16x8*)(KTt + (16 * nt + fr) * 136 + 32 * ks + 8 * fq), *(const bf16x8*)(QT + (16 * mt + fr) * 136 + 32 * ks + 8 * fq), sc);
                const int t = 16 * mt + fr, s0 = 16 * nt + 4 * fq;
#pragma unroll
                for (int r = 0; r < 4; ++r) if (s0 + r > t) sc[r] = 0.f;
            }
            u32x2 pw; pw.x = cvt_pk_bf16(sc[0], sc[1]); pw.y = cvt_pk_bf16(sc[2], sc[3]);
            *(u32x2*)(PM + (16 * mt + fr) * 72 + 16 * nt + 4 * fq) = pw;
        }
    }
    {
        f32x4 ak[2][8];
#pragma unroll
        for (int e = 0; e < 2; ++e)
#pragma unroll
            for (int nt = 0; nt < 8; ++nt) ak[e][nt] = (f32x4){0.f, 0.f, 0.f, 0.f};
#pragma unroll
        for (int ks = 0; ks < 2; ++ks) {
            const bf16x8 a0 = *(const bf16x8*)(VT + (32 * w + fr) * 72 + 32 * ks + 8 * fq), a1 = *(const bf16x8*)(VT + (32 * w + 16 + fr) * 72 + 32 * ks + 8 * fq);
#pragma unroll
            for (int nt = 0; nt < 8; ++nt) { const bf16x8 bfr = *(const bf16x8*)(KET + (16 * nt + fr) * 72 + 32 * ks + 8 * fq); ak[0][nt] = mma16(bfr, a0, ak[0][nt]); ak[1][nt] = mma16(bfr, a1, ak[1][nt]); }
        }
#pragma unroll
        for (int e = 0; e < 2; ++e)
#pragma unroll
            for (int nt = 0; nt < 8; ++nt) { u32x2 pw; pw.x = cvt_pk_bf16(ak[e][nt][0], ak[e][nt][1]); pw.y = cvt_pk_bf16(ak[e][nt][2], ak[e][nt][3]);
                *(u32x2*)(KVC + (size_t)(32 * w + 16 * e + fr) * 128 + 16 * nt + 4 * fq) = pw; }
    }
    __syncthreads();
    {
        const int mt = w & 3, nt0 = 8 * (w >> 2);
        f32x4 ao[8];
#pragma unroll
        for (int e = 0; e < 8; ++e) ao[e] = (f32x4){0.f, 0.f, 0.f, 0.f};
#pragma unroll
        for (int ks = 0; ks < 2; ++ks) { const bf16x8 af = *(const bf16x8*)(PM + (16 * mt + fr) * 72 + 32 * ks + 8 * fq);
#pragma unroll
            for (int e = 0; e < 8; ++e) ao[e] = mma16(*(const bf16x8*)(VT + (16 * (nt0 + e) + fr) * 72 + 32 * ks + 8 * fq), af, ao[e]); }
        const size_t row = rowc + 16 * mt + fr;
#pragma unroll
        for (int e = 0; e < 8; ++e) { u32x2 pw; pw.x = cvt_pk_bf16(ao[e][0], ao[e][1]); pw.y = cvt_pk_bf16(ao[e][2], ao[e][3]);
            *(u32x2*)(OG + row * 1024 + h * 256 + 16 * (nt0 + e) + 4 * fq) = pw; }
    }
    __syncthreads();
}
__device__ __forceinline__ void gla_b_scan(const Args& a, int bx, int G, int tid) {
    unsigned char* ws = a.ws;
    const bf16_t* KVC = (const bf16_t*)(ws + WS_KVC); bf16_t* SPREV = (bf16_t*)(ws + WS_SPREV); const float* DECG = (const float*)(ws + WS_DECG);
    for (int gid = bx * 512 + tid; gid < 16 * 8192; gid += G * 512) {
        const int bh = gid >> 13, e = gid & 8191, dv = e >> 5, dk0 = (e & 31) * 4;
        f32x4 S = (f32x4){0.f, 0.f, 0.f, 0.f};
#pragma unroll 8
        for (int c = 0; c < 32; ++c) {
            const size_t task = (size_t)bh * 32 + c;
            const u32x2 kv = __builtin_nontemporal_load((const u32x2*)(KVC + task * 32768 + (size_t)e * 4)); const f32x4 dc = *(const f32x4*)(DECG + task * 128 + dk0);
            u32x2 sp; sp.x = cvt_pk_bf16(S[0], S[1]); sp.y = cvt_pk_bf16(S[2], S[3]);
            *(u32x2*)(SPREV + task * 32768 + (size_t)e * 4) = sp;
            S[0] = dc[0] * S[0] + bflo(kv.x); S[1] = dc[1] * S[1] + bfhi(kv.x); S[2] = dc[2] * S[2] + bflo(kv.y); S[3] = dc[3] * S[3] + bfhi(kv.y);
        }
#pragma unroll
        for (int i = 0; i < 4; ++i) a.out[O_GLA_P + ((size_t)bh * 128 + dk0 + i) * 256 + dv] = S[i];
    }
}
__device__ __forceinline__ void gla_c_task(const Args& a, int task, int tid, int w, int lane) {
    unsigned char* ws = a.ws; const int fr = lane & 15, fq = lane >> 4;
    const int b = task >> 7, h = (task >> 5) & 3, c = task & 31;
    float* RED = (float*)smem;
    float* RINV = (float*)(smem + 512);
    const bf16_t* PROJ = (const bf16_t*)(ws + WS_PROJ); const bf16_t* OG = (const bf16_t*)(ws + WS_OG);
    const bf16_t* SPREV = (const bf16_t*)(ws + WS_SPREV) + (size_t)task * 32768; const bf16_t* QTG = (const bf16_t*)(ws + WS_QTG) + (size_t)task * 8192;
    const size_t rowc = (size_t)b * 2048 + (size_t)c * 64;
    if (tid < 64) {
        const float* sp = (const float*)(ws + WS_S5SS) + (rowc + tid) * 64; float s = 0.f;
#pragma unroll
        for (int i = 0; i < 16; ++i) { const f32x4 v = *(const f32x4*)(sp + 4 * i); s += (v[0] + v[1]) + (v[2] + v[3]); }
        const float m = s * (1.0f / 1024.0f) + EPS;
        RINV[tid] = sqrtf(m);
        if (h == 0) ((float*)(ws + WS_RS5))[rowc + tid] = rsqrtf(m);
    }
    const int mt = w & 3, nt0 = 8 * (w >> 2);
    const size_t row = rowc + 16 * mt + fr;
    bf16_t* SPV = (bf16_t*)(smem + 1024);
    bf16_t* QTL = (bf16_t*)(smem + 1024 + 69632);
    {
        u32x4 t[8], tq_[2];
#pragma unroll
        for (int i = 0; i < 8; ++i) t[i] = __builtin_nontemporal_load((const u32x4*)(SPREV + (size_t)(tid + 512 * i) * 8));
#pragma unroll
        for (int i = 0; i < 2; ++i) tq_[i] = *(const u32x4*)(QTG + (size_t)(tid + 512 * i) * 8);
#pragma unroll
        for (int i = 0; i < 8; ++i) { const int idx = tid + 512 * i, rr = idx >> 4, ch = idx & 15; *(u32x4*)(SPV + rr * 136 + ch * 8) = t[i]; }
#pragma unroll
        for (int i = 0; i < 2; ++i) { const int idx = tid + 512 * i, rr = idx >> 4, ch = idx & 15; *(u32x4*)(QTL + rr * 136 + ch * 8) = tq_[i]; }
    }
    f32x4 acc[8];
#pragma unroll
    for (int e = 0; e < 8; ++e) { const u32x2 v = *(const u32x2*)(OG + row * 1024 + h * 256 + 16 * (nt0 + e) + 4 * fq); acc[e] = (f32x4){bflo(v.x), bfhi(v.x), bflo(v.y), bfhi(v.y)}; }
    __syncthreads();
#pragma unroll
    for (int ks = 0; ks < 4; ++ks) { const bf16x8 af = *(const bf16x8*)(QTL + (16 * mt + fr) * 136 + 32 * ks + 8 * fq);
#pragma unroll
        for (int e = 0; e < 8; ++e) acc[e] = mma16(*(const bf16x8*)(SPV + (16 * (nt0 + e) + fr) * 136 + 32 * ks + 8 * fq), af, acc[e]); }
    float ss = 0.f;
#pragma unroll
    for (int e = 0; e < 8; ++e) ss += (acc[e][0] * acc[e][0] + acc[e][1] * acc[e][1]) + (acc[e][2] * acc[e][2] + acc[e][3] * acc[e][3]);
    ss += __shfl_xor(ss, 16); ss += __shfl_xor(ss, 32);
    if (fq == 0) RED[(w >> 2) * 64 + 16 * mt + fr] = ss;
    __syncthreads();
    const float rh = rsqrtf((RED[16 * mt + fr] + RED[64 + 16 * mt + fr]) * (1.0f / 256.0f) + EPS) * RINV[16 * mt + fr];
    const float* ng = a.in[24];
#pragma unroll
    for (int e = 0; e < 8; ++e) {
        const int dv = 16 * (nt0 + e) + 4 * fq;
        const f32x4 g = *(const f32x4*)(ng + dv); const u32x2 rv = *(const u32x2*)(PROJ + row * 3072 + 2048 + h * 256 + dv);
        u32x2 o; o.x = cvt_pk_bf16(acc[e][0] * rh * g[0] * bflo(rv.x), acc[e][1] * rh * g[1] * bfhi(rv.x)); o.y = cvt_pk_bf16(acc[e][2] * rh * g[2] * bflo(rv.y), acc[e][3] * rh * g[3] * bfhi(rv.y));
        *(u32x2*)((bf16_t*)(ws + WS_YCAT) + row * 2048 + 1024 + h * 256 + dv) = o;
    }
    __syncthreads();
}
__device__ __forceinline__ void gla_sample_task(const Args& a, int task, int tid, int w, int lane) {
    unsigned char* ws = a.ws; const int b = task >> 2, h = task & 3;
    f32x4* AKQ = (f32x4*)smem;
    float* ORED = (float*)(smem + 8192);
    float* SSW = (float*)(smem + 40960);
    float* RINV = (float*)(smem + 40960 + 64);
    const bf16_t* PROJ = (const bf16_t*)(ws + WS_PROJ); const float* GLOW = (const float*)(ws + WS_GLOW);
    {
        const int dk = tid & 127, j = tid >> 7; const size_t row = (size_t)NPR + 4 * b + j;
        float z = a.in[23][h * 128 + dk];
#pragma unroll
        for (int q = 0; q < 16; ++q) z += GLOW[row * 16 + q] * a.in[22][q * 512 + h * 128 + dk];
        const float dec = __expf(logsigmoid1(z) * 0.0625f);
        AKQ[j * 128 + dk] = (f32x4){dec, bf2f(PROJ[row * 3072 + 512 + h * 128 + dk]), bf2f(PROJ[row * 3072 + h * 128 + dk]), 0.f};
    }
    const int dv0 = 4 * lane;
    const size_t sbase = ((size_t)(b * 4 + h) * 128 + 16 * w) * 256 + dv0;
    f32x4 S[16];
#pragma unroll
    for (int i = 0; i < 16; ++i) S[i] = __builtin_nontemporal_load((const f32x4*)(a.in[7] + sbase + (size_t)i * 256));
    __syncthreads();
#pragma unroll
    for (int j = 0; j < 4; ++j) {
        const u32x2 vv = *(const u32x2*)(PROJ + ((size_t)NPR + 4 * b + j) * 3072 + 1024 + h * 256 + dv0);
        const f32x4 v = (f32x4){bflo(vv.x), bfhi(vv.x), bflo(vv.y), bfhi(vv.y)}; f32x4 op = (f32x4){0.f, 0.f, 0.f, 0.f};
#pragma unroll
        for (int i = 0; i < 16; ++i) { const f32x4 q = AKQ[j * 128 + 16 * w + i]; S[i] = S[i] * q[0] + v * q[1]; op += S[i] * q[2]; }
        *(f32x4*)(ORED + (w * 4 + j) * 256 + dv0) = op;
    }
#pragma unroll
    for (int i = 0; i < 16; ++i) __builtin_nontemporal_store(S[i], (f32x4*)(a.out + O_GLA_S + sbase + (size_t)i * 256));
    __syncthreads();
    const int j = tid >> 7, dvp = 2 * (tid & 127); const size_t row = (size_t)NPR + 4 * b + j;
    f32x2 o = (f32x2){0.f, 0.f};
#pragma unroll
    for (int gq = 0; gq < 8; ++gq) o += *(const f32x2*)(ORED + (gq * 4 + j) * 256 + dvp);
    { const float ss = wave_sum(o[0] * o[0] + o[1] * o[1]); if (lane == 0) SSW[j * 2 + (w & 1)] = ss; }
    if (w < 4) {
        const size_t rw = (size_t)NPR + 4 * b + w;
        const float sm = wave_sum(((const float*)(ws + WS_S5SS))[rw * 64 + lane]); const float m = sm * (1.0f / 1024.0f) + EPS;
        if (lane == 0) { RINV[w] = sqrtf(m); if (h == 0) ((float*)(ws + WS_RS5))[rw] = rsqrtf(m); }
    }
    __syncthreads();
    {
        const float rh = rsqrtf((SSW[j * 2] + SSW[j * 2 + 1]) * (1.0f / 256.0f) + EPS) * RINV[j];
        const f32x2 g = *(const f32x2*)(a.in[24] + dvp); const unsigned rv = *(const unsigned*)(PROJ + row * 3072 + 2048 + h * 256 + dvp);
        *(unsigned*)((bf16_t*)(ws + WS_YCAT) + row * 2048 + 1024 + h * 256 + dvp) = cvt_pk_bf16(o[0] * rh * g[0] * bflo(rv), o[1] * rh * g[1] * bfhi(rv));
    }
    __syncthreads();
}
__device__ __forceinline__ void attn_prompt_task(const Args& a, int task, int tid, int w, int lane) {
    unsigned char* ws = a.ws; const int fr = lane & 15, fq = lane >> 4;
    const int b = task >> 6, h = (task >> 4) & 3, blk = task & 15;
    bf16_t* KC = (bf16_t*)smem;
    bf16_t* VC = (bf16_t*)(smem + 66560);
    const bf16_t* QX = (const bf16_t*)(ws + WS_QX); const bf16_t* MKB = (const bf16_t*)(ws + WS_MKB); const bf16_t* MVT = (const bf16_t*)(ws + WS_MVT);
    bf16_t* OX = (bf16_t*)(ws + WS_OX);
    const size_t row = (size_t)b * 2048 + blk * 128 + 16 * w + fr;
    f32x4 sacc[16];
#pragma unroll
    for (int nt = 0; nt < 16; ++nt) sacc[nt] = (f32x4){0.f, 0.f, 0.f, 0.f};
    {
        u32x4 kr[8];
#pragma unroll
        for (int it = 0; it < 8; ++it) { const int idx = tid + 512 * it, rr = idx >> 6, ch = idx & 63; kr[it] = *(const u32x4*)(MKB + ((size_t)b * 256 + rr) * 2048 + h * 512 + ch * 8); }
#pragma unroll
        for (int mc = 0; mc < 4; ++mc) {
#pragma unroll
            for (int it = 0; it < 8; ++it) { const int idx = tid + 512 * it, rr = idx >> 6, ch = idx & 63; *(u32x4*)(KC + rr * 520 + ch * 8) = kr[it]; }
            __syncthreads();
            if (mc < 3) {
#pragma unroll
                for (int it = 0; it < 8; ++it) { const int idx = tid + 512 * it, rr = idx >> 6, ch = idx & 63; kr[it] = *(const u32x4*)(MKB + ((size_t)b * 256 + 64 * (mc + 1) + rr) * 2048 + h * 512 + ch * 8); }
            }
#pragma unroll
            for (int ks = 0; ks < 16; ++ks) {
                const bf16x8 aq = ldg8(QX + row * 2048 + h * 512 + 32 * ks + 8 * fq);
#pragma unroll
                for (int ntl = 0; ntl < 4; ++ntl) sacc[4 * mc + ntl] = mma16(*(const bf16x8*)(KC + (16 * ntl + fr) * 520 + 32 * ks + 8 * fq), aq, sacc[4 * mc + ntl]);
                if ((ks & 3) == 3) asm volatile("" ::: "memory");
            }
            __syncthreads();
        }
    }
    u32x4 vr[4];
#pragma unroll
    for (int it = 0; it < 4; ++it) { const int idx = tid + 512 * it, rr = idx >> 3, ch = idx & 7; vr[it] = *(const u32x4*)(MVT + ((size_t)h * 512 + rr) * 1024 + b * 256 + ch * 8); }
    float mx = -3.0e38f;
#pragma unroll
    for (int nt = 0; nt < 16; ++nt) mx = fmaxf(mx, fmaxf(fmaxf(sacc[nt][0], sacc[nt][1]), fmaxf(sacc[nt][2], sacc[nt][3])));
    mx = fmaxf(mx, __shfl_xor(mx, 16)); mx = fmaxf(mx, __shfl_xor(mx, 32));
    float lsum = 0.f;
#pragma unroll
    for (int nt = 0; nt < 16; ++nt)
#pragma unroll
        for (int r = 0; r < 4; ++r) { const float e = __expf(sacc[nt][r] - mx); sacc[nt][r] = e; lsum += e; }
    lsum += __shfl_xor(lsum, 16); lsum += __shfl_xor(lsum, 32);
    const float linv = 1.0f / lsum;
    bf16x8 ap[8];
#pragma unroll
    for (int ks = 0; ks < 8; ++ks) ap[ks] = pack8(sacc[2 * ks], sacc[2 * ks + 1]);
#pragma unroll 1
    for (int dh = 0; dh < 2; ++dh) {
        f32x4 oacc[16];
#pragma unroll
        for (int nt = 0; nt < 16; ++nt) oacc[nt] = (f32x4){0.f, 0.f, 0.f, 0.f};
#pragma unroll
        for (int mc = 0; mc < 4; ++mc) {
#pragma unroll
            for (int it = 0; it < 4; ++it) { const int idx = tid + 512 * it, rr = idx >> 3, ch = idx & 7; *(u32x4*)(VC + rr * 72 + ch * 8) = vr[it]; }
            __syncthreads();
            {
                const int st = dh * 4 + mc + 1;
                if (st < 8) {
                    const int ndh = st >> 2, nmc = st & 3;
#pragma unroll
                    for (int it = 0; it < 4; ++it) { const int idx = tid + 512 * it, rr = idx >> 3, ch = idx & 7; vr[it] = *(const u32x4*)(MVT + ((size_t)h * 512 + ndh * 256 + rr) * 1024 + b * 256 + 64 * nmc + ch * 8); }
                }
            }
#pragma unroll
            for (int ksl = 0; ksl < 2; ++ksl)
#pragma unroll
                for (int nt = 0; nt < 16; ++nt) {
                    const bf16_t* vp = VC + (16 * nt + fr) * 72 + 32 * ksl + 4 * fq;
                    const u32x2 lo = *(const u32x2*)vp, hi = *(const u32x2*)(vp + 16);
                    const u32x4 bw = (u32x4){lo.x, lo.y, hi.x, hi.y};
                    oacc[nt] = mma16(__builtin_bit_cast(bf16x8, bw), ap[2 * mc + ksl], oacc[nt]);
                }
            __syncthreads();
        }
#pragma unroll
        for (int nt = 0; nt < 16; ++nt) { u32x2 pw; pw.x = cvt_pk_bf16(oacc[nt][0] * linv, oacc[nt][1] * linv); pw.y = cvt_pk_bf16(oacc[nt][2] * linv, oacc[nt][3] * linv);
            *(u32x2*)(OX + row * 2048 + h * 512 + dh * 256 + 16 * nt + 4 * fq) = pw; }
    }
}
__device__ __forceinline__ float reduce16(const float (&p)[16], int lane) {
    float a8[8], a4[4], a2[2];
#pragma unroll
    for (int i = 0; i < 8; ++i) { const bool hi = (lane & 32) != 0; const float send = hi ? p[i] : p[i + 8], keep = hi ? p[i + 8] : p[i]; a8[i] = keep + __shfl_xor(send, 32); }
#pragma unroll
    for (int i = 0; i < 4; ++i) { const bool hi = (lane & 16) != 0; const float send = hi ? a8[i] : a8[i + 4], keep = hi ? a8[i + 4] : a8[i]; a4[i] = keep + __shfl_xor(send, 16); }
#pragma unroll
    for (int i = 0; i < 2; ++i) { const bool hi = (lane & 8) != 0; const float send = hi ? a4[i] : a4[i + 2], keep = hi ? a4[i + 2] : a4[i]; a2[i] = keep + __shfl_xor(send, 8); }
    const bool hi = (lane & 4) != 0; const float send = hi ? a2[0] : a2[1], keep = hi ? a2[1] : a2[0];
    float d = keep + __shfl_xor(send, 4);
    d += __shfl_xor(d, 2); d += __shfl_xor(d, 1);
    return d;
}
__device__ __forceinline__ f32x4 attn_q_combine(const Args& a, int task, int tid) {
    unsigned char* ws = a.ws; const int b = task >> 2, h = task & 3;
    const float* SLAB = (const float*)(ws + WS_SLAB); const float* R2 = (const float*)(ws + WS_R2);
    const int j = tid >> 7, c4 = (tid & 127) * 4;
    const int rs = 4 * b + j, pmq = rs >> 8, rr = rs & 255, col = h * 512 + c4, pn = col >> 8, cc = col & 255;
    const float* p = SLAB + (size_t)((pmq * 8 + pn) * 8) * 65536 + (size_t)rr * 256 + cc;
    f32x4 s0 = (f32x4){0.f, 0.f, 0.f, 0.f};
#pragma unroll
    for (int ks = 0; ks < 8; ++ks) s0 += *(const f32x4*)(p + (size_t)ks * 65536);
    return s0 * (R2[NPR + rs] * 0.04419417382415922f);
}
__device__ __forceinline__ void attn_sample_task(const Args& a, int task, int tid, int w, int lane, const f32x4 qpre) {
    unsigned char* ws = a.ws; const int b = task >> 2, h = task & 3;
    float* SC = (float*)smem;
    float* PS = (float*)(smem + 4096);
    float* RED = (float*)(smem + 8192);
    bf16_t* OX = (bf16_t*)(ws + WS_OX);
    float qv[4][8];
    {
        float* QL = RED;
        *(f32x4*)(QL + (tid >> 7) * 512 + (tid & 127) * 4) = qpre;
        __syncthreads();
#pragma unroll
        for (int j = 0; j < 4; ++j) { const f32x4 q0 = *(const f32x4*)(QL + j * 512 + 4 * lane), q1 = *(const f32x4*)(QL + j * 512 + 256 + 4 * lane);
#pragma unroll
            for (int d = 0; d < 4; ++d) { qv[j][d] = q0[d]; qv[j][4 + d] = q1[d]; } }
    }
    const float* Kb = a.in[3] + (((size_t)b * 256 + w) * 4 + h) * 512 + 4 * lane;
    const float* Vb = a.in[4] + (((size_t)b * 256 + w) * 4 + h) * 512 + 4 * lane;
    {
        f32x4 kb[2][8];
        const float* kp = Kb;
#pragma unroll
        for (int e = 0; e < 4; ++e) { const float* p = kp + (size_t)e * 16384; kb[0][2 * e] = __builtin_nontemporal_load((const f32x4*)p); kb[0][2 * e + 1] = __builtin_nontemporal_load((const f32x4*)(p + 256)); }
#pragma unroll 1
        for (int mp = 0; mp < 4; ++mp) {
#pragma unroll
            for (int hf = 0; hf < 2; ++hf) {
                if (hf == 0 || mp < 3) {
#pragma unroll
                    for (int e = 0; e < 4; ++e) { const float* p = kp + (size_t)(4 * (hf + 1) + e) * 16384; kb[hf ^ 1][2 * e] = __builtin_nontemporal_load((const f32x4*)p); kb[hf ^ 1][2 * e + 1] = __builtin_nontemporal_load((const f32x4*)(p + 256)); } }
                float pp[16];
#pragma unroll
                for (int e = 0; e < 4; ++e) { const f32x4 k0 = kb[hf][2 * e], k1 = kb[hf][2 * e + 1];
#pragma unroll
                    for (int j = 0; j < 4; ++j) pp[4 * e + j] = (qv[j][0] * k0[0] + qv[j][1] * k0[1]) + (qv[j][2] * k0[2] + qv[j][3] * k0[3]) + (qv[j][4] * k1[0] + qv[j][5] * k1[1]) + (qv[j][6] * k1[2] + qv[j][7] * k1[3]); }
                const float tot = reduce16(pp, lane);
                if ((lane & 3) == 0) { const int v = lane >> 2, e = v >> 2, j = v & 3; SC[j * 256 + 8 * (8 * mp + 4 * hf + e) + w] = tot; }
            }
            kp += 8 * 16384;
        }
    }
    f32x4 vb[2][8];
#pragma unroll
    for (int e = 0; e < 4; ++e) { const float* p = Vb + (size_t)e * 16384; vb[0][2 * e] = __builtin_nontemporal_load((const f32x4*)p); vb[0][2 * e + 1] = __builtin_nontemporal_load((const f32x4*)(p + 256)); }
    __syncthreads();
    if (w < 4) {
        float v[4]; float mx = -3.0e38f;
#pragma unroll
        for (int i = 0; i < 4; ++i) { v[i] = SC[w * 256 + lane + 64 * i]; mx = fmaxf(mx, v[i]); }
        mx = wave_max(mx); float sum = 0.f;
#pragma unroll
        for (int i = 0; i < 4; ++i) { v[i] = __expf(v[i] - mx); sum += v[i]; }
        sum = wave_sum(sum); const float inv = 1.0f / sum;
#pragma unroll
        for (int i = 0; i < 4; ++i) PS[(lane + 64 * i) * 4 + w] = v[i] * inv;
    }
    __syncthreads();
    float o[4][8];
#pragma unroll
    for (int j = 0; j < 4; ++j)
#pragma unroll
        for (int e = 0; e < 8; ++e) o[j][e] = 0.f;
    {
        const float* vp = Vb;
#pragma unroll 1
        for (int mp = 0; mp < 4; ++mp) {
#pragma unroll
            for (int hf = 0; hf < 2; ++hf) {
                if (hf == 0 || mp < 3) {
#pragma unroll
                    for (int e = 0; e < 4; ++e) { const float* p = vp + (size_t)(4 * (hf + 1) + e) * 16384; vb[hf ^ 1][2 * e] = __builtin_nontemporal_load((const f32x4*)p); vb[hf ^ 1][2 * e + 1] = __builtin_nontemporal_load((const f32x4*)(p + 256)); } }
#pragma unroll
                for (int e = 0; e < 4; ++e) { const f32x4 pr = *(const f32x4*)(PS + (8 * (8 * mp + 4 * hf + e) + w) * 4); const f32x4 v0 = vb[hf][2 * e], v1 = vb[hf][2 * e + 1];
#pragma unroll
                    for (int j = 0; j < 4; ++j) {
#pragma unroll
                        for (int d = 0; d < 4; ++d) { o[j][d] += pr[j] * v0[d]; o[j][4 + d] += pr[j] * v1[d]; } } }
            }
            vp += 8 * 16384;
        }
    }
#pragma unroll
    for (int j = 0; j < 4; ++j) { float* rp = RED + (w * 4 + j) * 512 + 4 * lane; *(f32x4*)rp = (f32x4){o[j][0], o[j][1], o[j][2], o[j][3]}; *(f32x4*)(rp + 256) = (f32x4){o[j][4], o[j][5], o[j][6], o[j][7]}; }
    __syncthreads();
#pragma unroll
    for (int i = 0; i < 4; ++i) { const int idx = tid + 512 * i, j = idx >> 9, d = idx & 511; float sm = 0.f;
#pragma unroll
        for (int ww = 0; ww < 8; ++ww) sm += RED[(ww * 4 + j) * 512 + d];
        OX[((size_t)NPR + 4 * b + j) * 2048 + h * 512 + d] = f2bf(sm); }
    __syncthreads();
}
__device__ __forceinline__ void conv_fixup_tile(const Args& a, int pm, int tid) {
    unsigned char* ws = a.ws; bf16_t* ACT = (bf16_t*)(ws + WS_ACT);
    const float* HAL = (const float*)(ws + WS_HAL); const float* HFA = (const float*)(ws + WS_HFA); const float* HFG = (const float*)(ws + WS_HFG);
    const float* cw = a.in[34]; const float* cb = a.in[35];
    for (int rem = tid; rem < 1408; rem += 512) {
        const int c = rem * 4;
        const f32x4 w0 = *(const f32x4*)(cw + c), w1 = *(const f32x4*)(cw + DFF + c), w2 = *(const f32x4*)(cw + 2 * DFF + c), bb = *(const f32x4*)(cb + c);
        const f32x4 am2 = *(const f32x4*)(HAL + ((size_t)(pm - 1) * 2) * DFF + c), am1 = *(const f32x4*)(HAL + ((size_t)(pm - 1) * 2 + 1) * DFF + c);
        const f32x4 a0 = *(const f32x4*)(HFA + ((size_t)pm * 2) * DFF + c), a1 = *(const f32x4*)(HFA + ((size_t)pm * 2 + 1) * DFF + c);
        const f32x4 g0 = *(const f32x4*)(HFG + ((size_t)pm * 2) * DFF + c), g1 = *(const f32x4*)(HFG + ((size_t)pm * 2 + 1) * DFF + c);
        const f32x4 o0 = gelu4(bb + am2 * w0 + am1 * w1 + a0 * w2) * g0, o1 = gelu4(bb + am1 * w0 + a0 * w1 + a1 * w2) * g1;
        u32x2 p0, p1; p0.x = cvt_pk_bf16(o0[0], o0[1]); p0.y = cvt_pk_bf16(o0[2], o0[3]); p1.x = cvt_pk_bf16(o1[0], o1[1]); p1.y = cvt_pk_bf16(o1[2], o1[3]);
        *(u32x2*)(ACT + (size_t)(pm * 256) * DFF + c) = p0; *(u32x2*)(ACT + (size_t)(pm * 256 + 1) * DFF + c) = p1;
    }
}
template <int MODE>
__device__ __forceinline__ void reduce_rows(const Args& a, int nsl, int bx, int G, int wave, int lane) {
    unsigned char* ws = a.ws; const float* SLAB = (const float*)(ws + WS_SLAB);
    for (int rs = bx * NWAVES + wave; rs < NSM; rs += G * NWAVES) {
        const size_t row = (size_t)NPR + rs; const int pmq = rs >> 8, rr = rs & 255;
        f32x4 v[8];
#pragma unroll
        for (int j = 0; j < 8; ++j) v[j] = (f32x4){0.f, 0.f, 0.f, 0.f};
        {
            const float* p0 = SLAB + (size_t)(pmq * 8 * nsl) * 65536 + (size_t)rr * 256 + 4 * lane; const size_t jstep = (size_t)nsl * 65536;
#pragma unroll 2
            for (int ks = 0; ks < nsl; ++ks) {
#pragma unroll
                for (int j = 0; j < 8; ++j) v[j] += __builtin_nontemporal_load((const f32x4*)(p0 + (size_t)j * jstep + (size_t)ks * 65536));
            }
        }
        const float sc = (MODE == 0) ? ((const float*)(ws + WS_RS5))[row] : 1.0f; float ss = 0.f;
        const bf16_t* bb = (const bf16_t*)(ws + (MODE == 2 ? WS_X2B : WS_X3B)) + row * DM;
#pragma unroll
        for (int j = 0; j < 8; ++j) {
            f32x4 bv;
            if (MODE == 0) bv = ((const f32x4*)(a.in[1] + (size_t)rs * DM))[lane + 64 * j];
            else { const u32x2 w = ((const u32x2*)bb)[lane + 64 * j]; bv = (f32x4){bflo(w.x), bfhi(w.x), bflo(w.y), bfhi(w.y)}; }
            v[j] = bv + v[j] * sc; ss += (v[j][0] * v[j][0] + v[j][1] * v[j][1]) + (v[j][2] * v[j][2] + v[j][3] * v[j][3]);
        }
        ss = wave_sum(ss);
        if (MODE == 3) {
            const float r = rsqrtf(ss * (1.0f / 2048.0f) + EPS); const float* nf = a.in[37]; f32x4* y = (f32x4*)(a.out + O_Y + row * DM);
#pragma unroll
            for (int j = 0; j < 8; ++j) { const f32x4 g = ((const f32x4*)nf)[lane + 64 * j]; y[lane + 64 * j] = (v[j] * r) * g; }
        } else {
            bf16_t* XBo = (bf16_t*)(ws + (MODE == 0 ? WS_X2B : WS_X3B)) + row * DM; float* SS = (float*)(ws + (MODE == 0 ? WS_SS2 : WS_SS3));
#pragma unroll
            for (int j = 0; j < 8; ++j) { u32x2 w; w.x = cvt_pk_bf16(v[j][0], v[j][1]); w.y = cvt_pk_bf16(v[j][2], v[j][3]); ((u32x2*)XBo)[lane + 64 * j] = w; }
            if (lane < 32) SS[row * 32 + lane] = (lane == 0) ? ss : 0.f;
            if (lane == 0) ((float*)(ws + (MODE == 0 ? WS_R2 : WS_R3)))[row] = rsqrtf(ss * (1.0f / 2048.0f) + EPS);
        }
    }
}
__device__ __forceinline__ void final_norm(const Args& a, int bx, int G, int wave, int lane) {
    const float* SS4 = (const float*)(a.ws + WS_SS4); const float* nf = a.in[37]; const bf16_t* X4 = (const bf16_t*)(a.ws + WS_X2);
    for (int row = bx * NWAVES + wave; row < NPR; row += G * NWAVES) {
        const float ss = wave_sum(lane < 32 ? SS4[(size_t)row * 32 + lane] : 0.f); const float r = rsqrtf(ss * (1.0f / 2048.0f) + EPS);
        f32x4* y = (f32x4*)(a.out + O_Y + (size_t)row * DM); const u32x2* xb = (const u32x2*)(X4 + (size_t)row * DM);
#pragma unroll
        for (int j = 0; j < 8; ++j) { const f32x4 g = ((const f32x4*)nf)[lane + 64 * j]; const u32x2 w = __builtin_nontemporal_load(xb + lane + 64 * j);
            f32x4 v = (f32x4){bflo(w.x), bfhi(w.x), bflo(w.y), bfhi(w.y)}; v = v * r; v = v * g; __builtin_nontemporal_store(v, y + lane + 64 * j); }
    }
}

__device__ __forceinline__ void row_rsqrt_pass(const float* SS, float* RR, int bx, int G, int wave, int lane) {
    for (int row = bx * NWAVES + wave; row < NPR; row += G * NWAVES) {
        const float tot = wave_sum(lane < 32 ? SS[(size_t)row * 32 + lane] : 0.f);
        if (lane == 0) RR[row] = rsqrtf(tot * (1.0f / 2048.0f) + EPS);
    }
}
__global__ void __launch_bounds__(NWAVES * 64, 2) hymba_fwd(Args args) {
    int tid = threadIdx.x, lane = tid & 63, wave = __builtin_amdgcn_readfirstlane(tid >> 6);
    const int G = gridDim.x, bx = blockIdx.x;
    const int vcu = (G % 8 == 0) ? (bx % 8) * (G / 8) + bx / 8 : bx;
    unsigned char* ws = args.ws;
    unsigned* ctl = (unsigned*)(ws + WS_CTL);
    volatile LAS unsigned* MISC = (volatile LAS unsigned*)((LAS unsigned char*)smem + MISC_OFF);
    if (tid < 32) MISC[tid] = 0u;
    __syncthreads();
    XcdBarrier bar; bar.bar = ctl + CW_BAR + args.li * XCD_BAR_WORDS; bar.x = 0; bar.st = nullptr;
    if (MK_N_LAUNCHES == 1) bar = xcd_barrier_post(ctl + CW_BAR + args.li * XCD_BAR_WORDS, MISC + 8);
    const int lo = args.ph_lo, hi = args.ph_hi;
#ifndef PH_MASK
#define PH_MASK 0x3FFF
#endif
#define IN(k) (((PH_MASK >> (k)) & 1) && lo <= (k) && (k) < hi)
#ifndef TIMED_PHASE
#define TIMED_PHASE -1
#endif
#ifndef TIME_MULT
#define TIME_MULT 2
#endif
    if (TIMED_PHASE >= 0 && bx == 0 && tid == 0) { const unsigned long long t0_ = __builtin_amdgcn_s_memrealtime(); MISC[16] = (unsigned)t0_; MISC[17] = (unsigned)(t0_ >> 32); }
#define STAMP(k) do { if (TIMED_PHASE >= 0 && bx == 0) { if (threadIdx.x == 0) { const unsigned long long t_now = __builtin_amdgcn_s_memrealtime(); \
        if (TIMED_PHASE == (k)) { const unsigned long long t_pr = ((unsigned long long)MISC[17] << 32) | MISC[16]; const unsigned long long dl = (t_now - t_pr) * TIME_MULT; while (__builtin_amdgcn_s_memrealtime() - t_now < dl) __builtin_amdgcn_s_sleep(8); } \
        const unsigned long long t2_ = __builtin_amdgcn_s_memrealtime(); MISC[16] = (unsigned)t2_; MISC[17] = (unsigned)(t2_ >> 32); } __syncthreads(); } } while (0)
#define SEAM(k) do { if (IN(k) && IN((k) + 1)) xcd_barrier(bar); STAMP(k); asm volatile("" : "+v"(tid)); lane = tid & 63; wave = __builtin_amdgcn_readfirstlane(tid >> 6); } while (0)
    LAS unsigned char* lds = (LAS unsigned char*)smem;
    const size_t TS2048 = (size_t)256 * 2048 * 2, TS5632 = (size_t)256 * 5632 * 2;

    if (IN(0)) { p0_prologue(args, bx, G, tid, wave, lane); }
    SEAM(0);
    if (IN(1)) {
        pg8::SchedJ<3> S; S.G = G; S.c = bx; S.nt = 32; S.tstep = TS2048;
        S.jb[0] = pg8::JobDesc{(const char*)(ws + WS_XB), (const char*)(ws + WS_WIN), 34, 17};
        S.jb[1] = pg8::JobDesc{(const char*)(ws + WS_MEMB), (const char*)(ws + WS_WXKV), 4, 16};
        S.jb[2] = pg8::JobDesc{(const char*)(ws + WS_WXKV) + (size_t)2048 * 2048 * 2, (const char*)(ws + WS_MEMB), 8, 4};
        EpiP1 E{(const float*)(ws + WS_R1), (const float*)(ws + WS_RMEM), (bf16_t*)(ws + WS_U), (bf16_t*)(ws + WS_PROJ), (float*)(ws + WS_GLOW), args.out, (bf16_t*)(ws + WS_MKB), (bf16_t*)(ws + WS_MVT)};
        pg8::gemm_phase(lds, 2048, S, E, tid);
        {
            const int first = (G == 256) ? 162 : 0;
            if (bx >= first) { float* scr = (float*)smem + wave * 4160; const int nw = (G - first) * NWAVES;
                for (int it = TR_NITEMS - TR_DEFER + (bx - first) * NWAVES + wave; it < TR_NITEMS; it += nw) transpose_dispatch(args, it, scr, lane); }
        }
    }
    SEAM(1);
    if (IN(2)) {
        for (int t = bx; t < 256; t += G) s5_prompt_task(args, t >> 6, t & 63, tid, wave, lane);
        if (G == 256) {
            if (bx >= 192) { gla_a_task(args, 448 + (bx - 192), tid, wave, lane); s5_sample_task(args, bx - 192, tid, wave, lane); }
            else { for (int t = bx; t < 448; t += 192) gla_a_task(args, t, tid, wave, lane); }
        } else {
            for (int t = bx; t < 512; t += G) gla_a_task(args, t, tid, wave, lane);
            for (int t = G - 1 - bx; t < 64; t += G) s5_sample_task(args, t, tid, wave, lane);
        }
    }
    SEAM(2);
    if (IN(3)) {
        gla_b_scan(args, bx, G, tid);
        for (int t = bx; t < 512; t += G) gla_sample_task(args, t, tid, wave, lane);
    }
    SEAM(3);
    if (IN(4)) { for (int t = bx; t < 512; t += G) gla_c_task(args, t, tid, wave, lane); }
    SEAM(4);
    float* SLAB = (float*)(ws + WS_SLAB);
    if (IN(5)) {
        pg8::SchedMS S{(const char*)(ws + WS_YCAT), (const char*)(ws + WS_WOUT), G, bx, 32, 8, 4, TS2048};
        EpiRes<false> E{args.in[0], args.in[1], nullptr, (bf16_t*)(ws + WS_X2B), (float*)(ws + WS_SS2), (const float*)(ws + WS_RS5), SLAB, 8};
        pg8::gemm_phase(lds, 2048, S, E, tid);
    }
    SEAM(5);
    if (IN(6)) { reduce_rows<0>(args, 8, bx, G, wave, lane); row_rsqrt_pass((const float*)(ws + WS_SS2), (float*)(ws + WS_R2), bx, G, wave, lane); }
    SEAM(6);
    if (IN(7)) {
        pg8::SchedMS S{(const char*)(ws + WS_X2B), (const char*)(ws + WS_WXQ), G, bx, 32, 8, 4, TS2048};
        EpiScale E{(const float*)(ws + WS_R2), (bf16_t*)(ws + WS_QX), 0.04419417382415922f, SLAB, 8};
        pg8::gemm_phase(lds, 2048, S, E, tid);
    }
    SEAM(7);
    if (IN(8)) {
        if (G == 256) {
            f32x4* QP = (f32x4*)(smem + QPRE_OFF);
            { const f32x4 q0 = attn_q_combine(args, bx, tid), q1 = attn_q_combine(args, bx + 256, tid); QP[tid] = q0; QP[512 + tid] = q1; }
            attn_prompt_task(args, vcu, tid, wave, lane);
            attn_sample_task(args, bx, tid, wave, lane, QP[tid]);
            attn_sample_task(args, bx + 256, tid, wave, lane, QP[512 + tid]);
        } else {
            for (int t = vcu; t < 256; t += G) attn_prompt_task(args, t, tid, wave, lane);
            for (int t = bx; t < 512; t += G) attn_sample_task(args, t, tid, wave, lane, attn_q_combine(args, t, tid));
        }
    }
    SEAM(8);
    if (IN(9)) {
        pg8::SchedMS S{(const char*)(ws + WS_OX), (const char*)(ws + WS_WXO), G, bx, 32, 8, 4, TS2048};
        EpiRes<true> E{(const void*)(ws + WS_X2B), nullptr, nullptr, (bf16_t*)(ws + WS_X3B), (float*)(ws + WS_SS3), nullptr, SLAB, 8};
        pg8::gemm_phase(lds, 2048, S, E, tid);
    }
    SEAM(9);
    if (IN(10)) { reduce_rows<2>(args, 8, bx, G, wave, lane); row_rsqrt_pass((const float*)(ws + WS_SS3), (float*)(ws + WS_R3), bx, G, wave, lane); }
    SEAM(10);
    if (IN(11)) {
        pg8::SchedJ<2> S; S.G = G; S.c = bx; S.nt = 32; S.tstep = TS2048;
        S.jb[0] = pg8::JobDesc{(const char*)(ws + WS_X3B), (const char*)(ws + WS_WUP), 32, 44, 0};
        S.jb[1] = pg8::JobDesc{(const char*)(ws + WS_X3B) + (size_t)32 * TS2048, (const char*)(ws + WS_WUP), 2, 44, 32};
        EpiUp E{(const float*)(ws + WS_R3), (bf16_t*)(ws + WS_ACT), args.out, args.in[34], args.in[35], args.in[8], (float*)(ws + WS_HAL), (float*)(ws + WS_HFA), (float*)(ws + WS_HFG)};
        pg8::gemm_phase(lds, 2048, S, E, tid);
    }
    SEAM(11);
    if (IN(12)) {
        pg8::SchedMS S{(const char*)(ws + WS_ACT), (const char*)(ws + WS_WDN), G, bx, 88, 11, 8, TS5632};
        {
            pg8::Unit u;
            for (int i = 0; S.next(i, u); ++i) if (u.job == 0 && (u.pm & 7) != 0) conv_fixup_tile(args, u.pm, tid);
            asm volatile("s_waitcnt vmcnt(0)" ::: "memory"); __syncthreads();
        }
        EpiRes<true> E{(const void*)(ws + WS_X3B), nullptr, nullptr, (bf16_t*)(ws + WS_X2), (float*)(ws + WS_SS4), nullptr, SLAB, 11};
        pg8::gemm_phase(lds, 5632, S, E, tid);
    }
    SEAM(12);
    if (IN(13)) { final_norm(args, bx, G, wave, lane); reduce_rows<3>(args, 11, bx, G, wave, lane); }
    if (TIMED_PHASE == 13) { asm volatile("s_waitcnt vmcnt(0)" ::: "memory"); __syncthreads(); STAMP(13); }
#undef IN
#undef SEAM
}

extern "C" void kernel_launch(void* const* d_in, const int* in_sizes, int n_in, void* d_out, int out_size, void* d_ws, size_t ws_size, hipStream_t stream) {
    static int grid = 0;
    if (grid == 0) {
        if (n_in != 38 || (size_t)out_size != O_END || ws_size < WS_END2) { fprintf(stderr, "kernel_launch: unexpected shapes: n_in %d out %d ws %zu\n", n_in, out_size, ws_size); grid = -1; return; }
        int dev = 0, cus = 0, per_cu = 0;
        if (hipGetDevice(&dev) != hipSuccess || hipDeviceGetAttribute(&cus, hipDeviceAttributeMultiprocessorCount, dev) != hipSuccess) { grid = -1; return; }
        if (hipFuncSetAttribute((const void*)hymba_fwd, hipFuncAttributeMaxDynamicSharedMemorySize, LDS_BYTES) != hipSuccess) { fprintf(stderr, "kernel_launch: hipFuncSetAttribute failed\n"); grid = -1; return; }
        if (hipOccupancyMaxActiveBlocksPerMultiprocessor(&per_cu, (const void*)hymba_fwd, NWAVES * 64, LDS_BYTES) != hipSuccess || per_cu < 1) { fprintf(stderr, "kernel_launch: occupancy query reports %d\n", per_cu); }
        (void)hipGetLastError();
        grid = cus;
    }
    if (grid < 0) return;
    (void)hipMemsetAsync((char*)d_ws + WS_CTL, 0, CTL_ZERO_BYTES, stream);
    Args a{};
    for (int i = 0; i < 38; ++i) a.in[i] = (const float*)d_in[i];
    a.out = (float*)d_out; a.ws = (unsigned char*)d_ws;
#if MK_N_LAUNCHES == 1
    a.ph_lo = 0; a.ph_hi = MK_PH_END; a.li = 0;
    hipLaunchKernelGGL(hymba_fwd, dim3(grid), dim3(NWAVES * 64), LDS_BYTES, stream, a);
#else
    for (int ph = 0; ph < MK_PH_END; ++ph) { a.ph_lo = ph; a.ph_hi = ph + 1; a.li = 0; hipLaunchKernelGGL(hymba_fwd, dim3(grid), dim3(NWAVES * 64), LDS_BYTES, stream, a); }
#endif
}
```
